# Optimizing an MI355X kernel written in HIP

```python
import math
import jax, jax.numpy as jnp
from jax import lax
import numpy as np

D_MODEL = 1024
BATCH = 8
SEQ = 2048
DEPTH = 2
DEC_BATCH = 128
DEC_SEQ = 1
PAST_LEN = 16384
PAGE_SIZE = 128

CHUNK = 128
D_A = D_MODEL
GMLP_HEADS = 4
GMLP_HEAD_DIM = D_A // GMLP_HEADS
D_B = D_MODEL
SSM_GROUP = 16
SSM_GROUPS = D_B // SSM_GROUP
SSM_STATE = 64
D_FF = 4 * D_MODEL
N_IN = 2 * D_A + D_B + 2 * D_MODEL
EPS = 1e-6

kernel_name = "gmlp_s5_gated_hybrid_step"


def rmsnorm(x, g):
    xf = x.astype(jnp.float32)
    y = xf * lax.rsqrt(jnp.mean(xf * xf, axis=-1, keepdims=True) + EPS)
    return (y * g.astype(jnp.float32)).astype(x.dtype)


def causal_chunk_mix(v, w_s, b_s):
    bsz, L = v.shape[0], v.shape[1]
    lc = min(L, CHUNK)
    n = -(-L // lc)
    pad = n * lc - L
    w = jnp.tril(w_s[:, :lc, :lc])
    vp = jnp.pad(v, ((0, 0), (0, pad), (0, 0), (0, 0)))
    vp = vp.reshape(bsz, n, lc, GMLP_HEADS, GMLP_HEAD_DIM)
    out = jnp.einsum('hts,bcshd->bcthd', w, vp) + jnp.transpose(b_s[:, :lc])[None, None, :, :, None]
    return out.reshape(bsz, n * lc, GMLP_HEADS, GMLP_HEAD_DIM)[:, :L]


def _ssm_combine(left, right):
    a1, b1 = left
    a2, b2 = right
    return a2 * a1, a2 * b1 + b2


def s5_branch(xs, lam_re, lam_im, log_dt, b_re, b_im, c_re, c_im, d_skip, w_glu, b_glu, h0):
    f32 = jnp.float32
    bsz, L = xs.shape[0], xs.shape[1]
    xf = xs.astype(f32).reshape(bsz, L, SSM_GROUPS, SSM_GROUP)
    lam = lax.complex(lam_re.astype(f32), lam_im.astype(f32))
    dt = jnp.exp(log_dt.astype(f32))[:, None]
    a_bar = jnp.exp(lam * dt)
    b_mat = lax.complex(b_re.astype(f32), b_im.astype(f32))
    b_bar = ((a_bar - 1.0) / lam)[:, :, None] * b_mat
    c_mat = lax.complex(c_re.astype(f32), c_im.astype(f32))
    bu = jnp.einsum('blgh,gph->blgp', xf.astype(jnp.complex64), b_bar)
    if h0 is not None:
        bu = bu.at[:, 0].add(a_bar[None] * h0)
    a_full = jnp.broadcast_to(a_bar, bu.shape)
    _, hs = lax.associative_scan(_ssm_combine, (a_full, bu), axis=1)
    y = jnp.einsum('blgp,ghp->blgh', hs, c_mat).real + d_skip.astype(f32).reshape(SSM_GROUPS, SSM_GROUP) * xf
    z = jax.nn.gelu(y.reshape(bsz, L, D_B))
    out = z * jax.nn.sigmoid(z @ w_glu.astype(f32) + b_glu.astype(f32))
    return out.astype(xs.dtype), hs[:, -1]


def trunk(x, c, h0_re, h0_im, p, keep_v):
    bsz, L = x.shape[0], x.shape[1]
    re_list, im_list, v_list = [], [], []
    for l in range(DEPTH):
        mod = (jax.nn.silu(c) @ p['w_ada'][l] + p['b_ada'][l])[:, None, :]
        sh1, sc1, gt1, sh2, sc2, gt2 = jnp.split(mod, 6, axis=-1)
        h = rmsnorm(x, p['g_norm1'][l]) * (1.0 + sc1) + sh1
        proj = h @ p['w_in'][l]
        pu, pv, ps, pga, pgb = jnp.split(
            proj, [D_A, 2 * D_A, 2 * D_A + D_B, 2 * D_A + D_B + D_MODEL], axis=-1)
        u = jax.nn.gelu(pu)
        v = rmsnorm(jax.nn.gelu(pv), p['g_v'][l])
        mixed = causal_chunk_mix(v.reshape(bsz, L, GMLP_HEADS, GMLP_HEAD_DIM),
                                 p['w_spatial'][l], p['b_spatial'][l])
        y_a = u * mixed.reshape(bsz, L, D_A)
        h0 = None if h0_re is None else lax.complex(h0_re[l].astype(jnp.float32),
                                                     h0_im[l].astype(jnp.float32))
        y_b, h_last = s5_branch(ps, p['lam_re'][l], p['lam_im'][l], p['log_dt'][l],
                                p['b_re'][l], p['b_im'][l], p['c_re'][l], p['c_im'][l],
                                p['d_skip'][l], p['w_glu'][l], p['b_glu'][l], h0)
        merged = jax.nn.sigmoid(pga) * y_a + jax.nn.sigmoid(pgb) * y_b
        x = x + gt1 * (merged @ p['w_out'][l])
        h = rmsnorm(x, p['g_norm2'][l]) * (1.0 + sc2) + sh2
        x = x + gt2 * (jnp.square(jax.nn.relu(h @ p['w_ff1'][l])) @ p['w_ff2'][l])
        re_list.append(h_last.real)
        im_list.append(h_last.imag)
        if keep_v:
            v_list.append(v)
    y = rmsnorm(x, p['g_final'])
    v_stack = jnp.stack(v_list, axis=0) if keep_v else None
    return y, jnp.stack(re_list, axis=0), jnp.stack(im_list, axis=0), v_stack


def setup_inputs(seed: int = 0) -> dict:
    key = jax.random.key(seed)
    ks = jax.random.split(key, 32)
    f32 = jnp.float32
    nrm = lambda k, shape, s: jax.random.normal(k, shape, f32) * s
    lam_im = jnp.tile(math.pi * jnp.arange(SSM_STATE, dtype=f32)[None, None, :], (DEPTH, SSM_GROUPS, 1))
    return {
        "x_prompt": nrm(ks[0], (BATCH, SEQ, D_MODEL), 1.0),
        "x_sample": nrm(ks[1], (DEC_BATCH, DEC_SEQ, D_MODEL), 1.0),
        "c_prompt": nrm(ks[2], (BATCH, D_MODEL), 1.0),
        "c_sample": nrm(ks[3], (DEC_BATCH, D_MODEL), 1.0),
        "state_ssm_re": nrm(ks[4], (DEPTH, DEC_BATCH, SSM_GROUPS, SSM_STATE), 0.5),
        "state_ssm_im": nrm(ks[5], (DEPTH, DEC_BATCH, SSM_GROUPS, SSM_STATE), 0.5),
        "w_ada": nrm(ks[6], (DEPTH, D_MODEL, 6 * D_MODEL), 0.5 * D_MODEL ** -0.5),
        "b_ada": nrm(ks[7], (DEPTH, 6 * D_MODEL), 0.01),
        "g_norm1": 1.0 + nrm(ks[8], (DEPTH, D_MODEL), 0.05),
        "g_norm2": 1.0 + nrm(ks[9], (DEPTH, D_MODEL), 0.05),
        "w_in": nrm(ks[10], (DEPTH, D_MODEL, N_IN), D_MODEL ** -0.5),
        "g_v": 1.0 + nrm(ks[11], (DEPTH, D_A), 0.05),
        "w_spatial": nrm(ks[12], (DEPTH, GMLP_HEADS, CHUNK, CHUNK), CHUNK ** -0.5),
        "b_spatial": 1.0 + nrm(ks[13], (DEPTH, GMLP_HEADS, CHUNK), 0.1),
        "lam_re": -0.5 * jnp.exp(nrm(ks[14], (DEPTH, SSM_GROUPS, SSM_STATE), 0.05)),
        "lam_im": lam_im,
        "log_dt": jax.random.uniform(ks[15], (DEPTH, SSM_GROUPS), f32, math.log(1e-3), math.log(1e-1)),
        "b_re": nrm(ks[16], (DEPTH, SSM_GROUPS, SSM_STATE, SSM_GROUP), (2 * SSM_GROUP) ** -0.5),
        "b_im": nrm(ks[17], (DEPTH, SSM_GROUPS, SSM_STATE, SSM_GROUP), (2 * SSM_GROUP) ** -0.5),
        "c_re": nrm(ks[18], (DEPTH, SSM_GROUPS, SSM_GROUP, SSM_STATE), (2 * SSM_STATE) ** -0.5),
        "c_im": nrm(ks[19], (DEPTH, SSM_GROUPS, SSM_GROUP, SSM_STATE), (2 * SSM_STATE) ** -0.5),
        "d_skip": nrm(ks[20], (DEPTH, D_B), 1.0),
        "w_glu": nrm(ks[21], (DEPTH, D_B, D_B), D_B ** -0.5),
        "b_glu": nrm(ks[22], (DEPTH, D_B), 0.01),
        "w_out": nrm(ks[23], (DEPTH, D_MODEL, D_MODEL), D_MODEL ** -0.5),
        "w_ff1": nrm(ks[24], (DEPTH, D_MODEL, D_FF), D_MODEL ** -0.5),
        "w_ff2": nrm(ks[25], (DEPTH, D_FF, D_MODEL), D_FF ** -0.5),
        "g_final": 1.0 + nrm(ks[26], (D_MODEL,), 0.05),
    }


def reference(x_prompt, x_sample, c_prompt, c_sample, state_ssm_re, state_ssm_im,
              w_ada, b_ada, g_norm1, g_norm2, w_in, g_v, w_spatial, b_spatial,
              lam_re, lam_im, log_dt, b_re, b_im, c_re, c_im, d_skip, w_glu, b_glu,
              w_out, w_ff1, w_ff2, g_final):
    p = dict(w_ada=w_ada, b_ada=b_ada, g_norm1=g_norm1, g_norm2=g_norm2, w_in=w_in, g_v=g_v,
             w_spatial=w_spatial, b_spatial=b_spatial, lam_re=lam_re, lam_im=lam_im,
             log_dt=log_dt, b_re=b_re, b_im=b_im, c_re=c_re, c_im=c_im, d_skip=d_skip,
             w_glu=w_glu, b_glu=b_glu, w_out=w_out, w_ff1=w_ff1, w_ff2=w_ff2, g_final=g_final)
    y_prompt, ssm_re_prompt, ssm_im_prompt, _ = trunk(x_prompt, c_prompt, None, None, p, False)
    y_sample, ssm_re_sample, ssm_im_sample, gmlp_v_sample = trunk(
        x_sample, c_sample, state_ssm_re, state_ssm_im, p, True)
    return (y_prompt, y_sample, ssm_re_prompt, ssm_im_prompt, ssm_re_sample, ssm_im_sample, gmlp_v_sample)
```

```cpp
#include <hip/hip_runtime.h>
#include <hip/hip_cooperative_groups.h>
#include <cstdio>
#include <cstdint>
namespace cg = cooperative_groups;
namespace pg8 {
#define PG8_LAS __attribute__((address_space(3)))
typedef unsigned short bf16_t;
typedef short bf16x8 __attribute__((ext_vector_type(8)));
typedef float f32x4 __attribute__((ext_vector_type(4)));
typedef unsigned u32x4 __attribute__((ext_vector_type(4)));
constexpr int BM = 256, BK = 64, HALF = 128, HTB = HALF * BK * 2  , STAGE_BYTES = 8 * HTB, NXCD = 8, WGM = 8;

__host__ __device__ __forceinline__ int lds_byte(int r, int c) { const int st = (r >> 4) * 2 + (c >> 5), rr = r & 15, cc = c & 31, ob = rr * 64 + cc * 2; return st * 1024 + (ob ^ (((ob >> 9) & 1) << 5)); }
__host__ __device__ __forceinline__ void stage_rc(int b, int& R, int& C) { const int st = b / 1024, sb = b % 1024, swz = sb ^ (((sb >> 9) & 1) << 5); R = (st >> 1) * 16 + swz / 64; C = (st & 1) * 32 + (swz % 64) / 2; }
__host__ __device__ __forceinline__ int perm32(int rho) { const int n = rho >> 4, i = rho & 15; return 8 * (i >> 2) + 4 * n + (i & 3); }

struct Unit { int pm, pn; };
struct Gemm { const bf16_t* A; const bf16_t* Bt; int M, N, K; };

struct StaticOrder {
    int nM, nN, nwg, G, c;
    __host__ __device__ void init(int M, int N, int G_, int c_) { nM = M / BM; nN = N / BM; nwg = nM * nN; G = G_; c = c_; }
    __host__ __device__ bool next(int i, Unit& u) const {
        const long L = (long)i * G + c; if (L >= nwg) return false;
        int wgid = (int)L; { const int q = nwg / NXCD, r = nwg % NXCD, xcd = wgid % NXCD, off = wgid / NXCD; wgid = (xcd < r ? xcd * (q + 1) : r * (q + 1) + (xcd - r) * q) + off; }
        const int nig = WGM * nN, gid = wgid / nig, fm = gid * WGM, gsz = (nM - fm) < WGM ? (nM - fm) : WGM;
        u.pm = fm + ((wgid % nig) % gsz); u.pn = (wgid % nig) / gsz; return true;
    }
    __device__ __forceinline__ void a_ready(const Unit&) const {}
    __device__ __forceinline__ void done(const Unit&) const {}
};

__device__ __forceinline__ unsigned cvt_pk_bf16(float lo, float hi) { unsigned r; asm volatile("v_cvt_pk_bf16_f32 %0, %1, %2" : "=v"(r) : "v"(lo), "v"(hi)); return r; }
typedef float f32x2 __attribute__((ext_vector_type(2)));
template <class Epi, class Sched, bool ALIGN_EPI = false, bool SP2 = false>
__device__ __forceinline__ void gemm_phase(PG8_LAS unsigned char* lds, const Gemm g, const Sched& S, const Epi& E) {
    int tid = threadIdx.x; asm volatile("" : "+v"(tid)); const int wid = __builtin_amdgcn_readfirstlane(tid >> 6), lane = tid & 63, wr = wid >> 2, wc = wid & 3, fr = lane & 15, fq = lane >> 4;
    const int K = g.K, nt = K / BK;
    unsigned voffA[2], voffB[2];
#pragma unroll
    for (int i = 0; i < 2; ++i) { int R, C; stage_rc(tid * 16 + i * 8192, R, C); const int Rb = Epi::PERM ? ((R & ~31) + perm32(R & 31)) : R;
        voffA[i] = (unsigned)(R * K + C) * 2u; voffB[i] = (unsigned)(Rb * K + C) * 2u; }
    const size_t kstep = (size_t)(BK * 2);
    const size_t hstep = (size_t)HALF * K * 2;
    const size_t tstep = 2 * hstep;
    const unsigned ldsw = (unsigned)wid * 1024u;
    const int aoff = lds_byte(wr * 64 + fr, fq * 8), boff = lds_byte(wc * 32 + fr, fq * 8);
#define PG8_SA(b, h) (((b) * 2 + (h)) * HTB)
#define PG8_SB(b, h) ((4 + (b) * 2 + (h)) * HTB)
#define PG8_STAGE(bufoff, gbase, voff) do { _Pragma("unroll") for (int _i = 0; _i < 2; ++_i) \
        __builtin_amdgcn_global_load_lds((const unsigned*)((const char*)(gbase) + (voff)[_i]), (PG8_LAS unsigned*)(lds + (bufoff) + ldsw + _i * 8192), 16, 0, 0); } while (0)
#define PG8_LDA(dst, b, h) do { _Pragma("unroll") for (int m = 0; m < 4; ++m) _Pragma("unroll") for (int k = 0; k < 2; ++k) dst[m][k] = *(const PG8_LAS bf16x8*)(lds + PG8_SA(b, h) + aoff + m * 2048 + k * 1024); } while (0)
#define PG8_LDB(dst, b, h) do { _Pragma("unroll") for (int n = 0; n < 2; ++n) _Pragma("unroll") for (int k = 0; k < 2; ++k) dst[n][k] = *(const PG8_LAS bf16x8*)(lds + PG8_SB(b, h) + boff + n * 2048 + k * 1024); } while (0)
#define PG8_MMA(ai, bj, At, Bt) do { __builtin_amdgcn_s_setprio(1); _Pragma("unroll") for (int m = 0; m < 4; ++m) _Pragma("unroll") for (int n = 0; n < 2; ++n) _Pragma("unroll") for (int k = 0; k < 2; ++k) \
        acc[ai][bj][m][n] = __builtin_amdgcn_mfma_f32_16x16x32_bf16(Bt[n][k], At[m][k], acc[ai][bj][m][n], 0, 0, 0); __builtin_amdgcn_s_setprio(0); } while (0)
#define PG8_WAIT_V(n) asm volatile("s_waitcnt vmcnt(" #n ")" ::: "memory")
#define PG8_WAIT_L(n) asm volatile("s_waitcnt lgkmcnt(" #n ")" ::: "memory")
#define PG8_BAR __builtin_amdgcn_s_barrier()
#define PG8_SCHED __builtin_amdgcn_sched_barrier(0)
    Unit cur, nxt; int ui = 0;
    if (!S.next(0, cur)) return;
    f32x4 acc[2][2][4][2];
#pragma unroll
    for (int a = 0; a < 2; ++a)
#pragma unroll
        for (int b = 0; b < 2; ++b)
#pragma unroll
            for (int m = 0; m < 4; ++m)
#pragma unroll
                for (int n = 0; n < 2; ++n) acc[a][b][m][n] = (f32x4){0.f, 0.f, 0.f, 0.f};
    bf16x8 At[4][2], B0[2][2], B1[2][2];
    const char* cA = (const char*)g.A + (size_t)cur.pm * tstep; const char* cB = (const char*)g.Bt + (size_t)cur.pn * tstep;
    S.a_ready(cur);
    if constexpr (SP2) {
        PG8_STAGE(PG8_SB(0, 0), cB, voffB); PG8_STAGE(PG8_SB(0, 1), cB + hstep, voffB); PG8_STAGE(PG8_SA(0, 0), cA, voffA); PG8_STAGE(PG8_SA(0, 1), cA + hstep, voffA);
        if (wr == 1) PG8_BAR;
        PG8_WAIT_V(2); PG8_BAR;
        PG8_STAGE(PG8_SB(1, 0), cB + kstep, voffB); PG8_STAGE(PG8_SA(1, 0), cA + kstep, voffA); PG8_STAGE(PG8_SB(1, 1), cB + hstep + kstep, voffB);
        PG8_WAIT_V(6); PG8_BAR;
    } else {
        PG8_STAGE(PG8_SB(0, 0), cB, voffB); PG8_STAGE(PG8_SA(0, 0), cA, voffA); PG8_STAGE(PG8_SB(0, 1), cB + hstep, voffB); PG8_STAGE(PG8_SA(0, 1), cA + hstep, voffA);
        if (wr == 1) PG8_BAR;
        PG8_WAIT_V(4); PG8_BAR;
        PG8_STAGE(PG8_SB(1, 0), cB + kstep, voffB); PG8_STAGE(PG8_SA(1, 0), cA + kstep, voffA); PG8_STAGE(PG8_SB(1, 1), cB + hstep + kstep, voffB);
        PG8_WAIT_V(6); PG8_BAR;
    }
    for (;;) {
        const bool has_next = S.next(ui + 1, nxt);
        const char* nA = has_next ? (const char*)g.A + (size_t)nxt.pm * tstep : cA; const char* nB = has_next ? (const char*)g.Bt + (size_t)nxt.pn * tstep : cB;
        for (int t = 0; t < nt; t += 2) {
            const bool last = (t == nt - 2);
            const char* a1 = cA + (size_t)(t + 1) * kstep;
            const char* a2 = last ? nA : cA + (size_t)(t + 2) * kstep; const char* b2 = last ? nB : cB + (size_t)(t + 2) * kstep;
            const char* a3 = a2 + kstep; const char* b3 = b2 + kstep;
            if (last && has_next) S.a_ready(nxt);
            if constexpr (SP2) {
            PG8_LDB(B0, 0, 0); PG8_LDB(B1, 0, 1); PG8_SCHED; PG8_LDA(At, 0, 0); PG8_STAGE(PG8_SA(1, 1), a1 + hstep, voffA);
            PG8_WAIT_V(8); PG8_WAIT_L(0); PG8_BAR; PG8_MMA(0, 0, At, B0); PG8_MMA(0, 1, At, B1); PG8_BAR; PG8_SCHED;
            PG8_LDA(At, 0, 1); PG8_STAGE(PG8_SB(0, 0), b2, voffB); PG8_STAGE(PG8_SB(0, 1), b2 + hstep, voffB); PG8_STAGE(PG8_SA(0, 0), a2, voffA);
            PG8_WAIT_V(8); PG8_WAIT_L(0); PG8_BAR; PG8_MMA(1, 0, At, B0); PG8_MMA(1, 1, At, B1); PG8_BAR; PG8_SCHED;
            PG8_LDB(B0, 1, 0); PG8_LDB(B1, 1, 1); PG8_SCHED; PG8_LDA(At, 1, 0); PG8_STAGE(PG8_SA(0, 1), a2 + hstep, voffA);
            PG8_WAIT_V(8); PG8_WAIT_L(0); PG8_BAR; PG8_MMA(0, 0, At, B0); PG8_MMA(0, 1, At, B1); PG8_BAR; PG8_SCHED;
            PG8_LDA(At, 1, 1); PG8_STAGE(PG8_SB(1, 0), b3, voffB); PG8_STAGE(PG8_SB(1, 1), b3 + hstep, voffB); PG8_STAGE(PG8_SA(1, 0), a3, voffA);
            PG8_WAIT_V(8); PG8_WAIT_L(0); PG8_BAR; PG8_MMA(1, 0, At, B0); PG8_MMA(1, 1, At, B1); PG8_BAR; PG8_SCHED;
            } else {
            PG8_LDB(B0, 0, 0); PG8_SCHED; PG8_LDA(At, 0, 0); PG8_STAGE(PG8_SA(1, 1), a1 + hstep, voffA);
            PG8_WAIT_L(8); PG8_BAR; PG8_WAIT_L(0); PG8_MMA(0, 0, At, B0); PG8_BAR; PG8_SCHED;
            PG8_LDB(B1, 0, 1); PG8_STAGE(PG8_SB(0, 0), b2, voffB);
            PG8_BAR; PG8_WAIT_L(0); PG8_MMA(0, 1, At, B1); PG8_BAR;
            PG8_LDA(At, 0, 1); PG8_STAGE(PG8_SA(0, 0), a2, voffA);
            PG8_BAR; PG8_WAIT_L(0); PG8_MMA(1, 0, At, B0); PG8_BAR; PG8_SCHED;
            PG8_STAGE(PG8_SB(0, 1), b2 + hstep, voffB);
            PG8_WAIT_V(6); PG8_BAR; PG8_MMA(1, 1, At, B1); PG8_BAR;
            PG8_LDB(B0, 1, 0); PG8_SCHED; PG8_LDA(At, 1, 0); PG8_STAGE(PG8_SA(0, 1), a2 + hstep, voffA);
            PG8_WAIT_L(8); PG8_BAR; PG8_WAIT_L(0); PG8_MMA(0, 0, At, B0); PG8_BAR; PG8_SCHED;
            PG8_LDB(B1, 1, 1); PG8_STAGE(PG8_SB(1, 0), b3, voffB);
            PG8_BAR; PG8_WAIT_L(0); PG8_MMA(0, 1, At, B1); PG8_BAR;
            PG8_LDA(At, 1, 1); PG8_STAGE(PG8_SA(1, 0), a3, voffA);
            PG8_BAR; PG8_WAIT_L(0); PG8_MMA(1, 0, At, B0); PG8_BAR; PG8_SCHED;
            PG8_STAGE(PG8_SB(1, 1), b3 + hstep, voffB);
            PG8_WAIT_V(6); PG8_BAR; PG8_MMA(1, 1, At, B1); PG8_BAR;
            }
        }
        if constexpr (ALIGN_EPI) { if (wr == 0) PG8_BAR; }
        if constexpr (!Epi::AFTER_DRAIN) { E(acc, cur, wr, wc, fr, fq); S.done(cur); }
        if (!has_next) break;
#pragma unroll
        for (int a = 0; a < 2; ++a)
#pragma unroll
            for (int b = 0; b < 2; ++b)
#pragma unroll
                for (int m = 0; m < 4; ++m)
#pragma unroll
                    for (int n = 0; n < 2; ++n) acc[a][b][m][n] = (f32x4){0.f, 0.f, 0.f, 0.f};
        cur = nxt; cA = nA; cB = nB; ++ui;
        if constexpr (ALIGN_EPI) { if (wr == 1) PG8_BAR; }
    }
    PG8_WAIT_V(0);
    if constexpr (!ALIGN_EPI) { if (wr == 0) PG8_BAR; }
    PG8_BAR;
    if constexpr (Epi::AFTER_DRAIN) { E.fused(acc, cur, wr, wc, fr, fq, lds, wid, lane); S.done(cur); }
#undef PG8_SA
#undef PG8_SB
#undef PG8_STAGE
#undef PG8_LDA
#undef PG8_LDB
#undef PG8_MMA
#undef PG8_WAIT_V
#undef PG8_WAIT_L
#undef PG8_BAR
#undef PG8_SCHED
}
}

typedef unsigned short bf16;
typedef short bf16x8 __attribute__((ext_vector_type(8)));
typedef float f32x4 __attribute__((ext_vector_type(4)));
typedef unsigned u32x4 __attribute__((ext_vector_type(4)));
typedef unsigned u32x2 __attribute__((ext_vector_type(2)));
#define LAS __attribute__((address_space(3)))

constexpr int D = 1024, NP = 16384, NS = 128, NR = NP + NS, NIN = 5120, FF = 4096;
constexpr int NMODR = 136, NMODC = 6144;
constexpr float EPS = 1e-6f;
constexpr int LDS_BYTES = 148 * 1024;

enum { I_XP = 0, I_XS, I_CP, I_CS, I_SRE, I_SIM, I_WADA, I_BADA, I_G1, I_G2, I_WIN, I_GV, I_WSP, I_BSP, I_LRE, I_LIM, I_LDT,
       I_BRE, I_BIM, I_CRE, I_CIM, I_DSK, I_WGLU, I_BGLU, I_WOUT, I_WFF1, I_WFF2, I_GFIN };
constexpr size_t O_YP = 0, O_YS = 16777216, O_RP = O_YS + 131072, O_IP = O_RP + 65536, O_RS = O_IP + 65536, O_IS = O_RS + 1048576, O_V = O_IS + 1048576;
constexpr size_t MiB = 1u << 20;
constexpr size_t ACTB = (size_t)NR * D * 2;
constexpr size_t WS_SSQ = 0, WS_CSILU = 1 * MiB, WS_WSB = 2 * MiB, WS_SMALL = 3 * MiB, WS_MOD = 6 * MiB, WS_S5F = 13 * MiB, WS_KTAB = 14 * MiB,
                 WS_WS = 16 * MiB, WS_WY = 24 * MiB, WS_WIN = 32 * MiB, WS_WGLU = 42 * MiB, WS_WOUT = 44 * MiB, WS_WFF1 = 46 * MiB, WS_WFF2 = 54 * MiB,
                 WS_SC = 62 * MiB, WS_HIN = 78 * MiB, WS_B0 = 86 * MiB, WS_B1 = WS_B0 + ACTB, WS_B2 = WS_B1 + ACTB, WS_B3 = WS_B2 + ACTB, WS_B4 = WS_B3 + ACTB,
                 WS_END = WS_B4 + ACTB;
constexpr size_t SMALLB = (size_t)NS * D * 4;

struct Params { const float* in[28]; float* out; unsigned char* ws; };

__device__ __forceinline__ float bf2f(unsigned b) { return __uint_as_float(b << 16); }
__device__ __forceinline__ unsigned f2bf(float f) { unsigned u = __float_as_uint(f); return (u + 0x7fffu + ((u >> 16) & 1u)) >> 16; }
__device__ __forceinline__ unsigned pk2(float lo, float hi) { return pg8::cvt_pk_bf16(lo, hi); }
__device__ __forceinline__ float blo(unsigned w) { return __uint_as_float(w << 16); }
__device__ __forceinline__ float bhi(unsigned w) { return __uint_as_float(w & 0xffff0000u); }
__device__ __forceinline__ float sigmoid_f(float x) { return __builtin_amdgcn_rcpf(1.0f + __builtin_amdgcn_exp2f(-1.4426950409f * x)); }
__device__ __forceinline__ float gelu_t(float x) { const float y = x * (1.5957691216f + 0.0713548163f * x * x); return x * __builtin_amdgcn_rcpf(1.0f + __builtin_amdgcn_exp2f(-1.4426950409f * y)); }
__device__ __forceinline__ float wave_sum(float v) {
#pragma unroll
    for (int o = 1; o < 64; o <<= 1) v += __shfl_xor(v, o);
    return v;
}
__device__ __forceinline__ int otid() { int t = threadIdx.x; asm volatile("" : "+v"(t)); return t; }
#define LDS_FENCE() asm volatile("s_waitcnt lgkmcnt(0)" ::: "memory")
#define MFMA16(a, b, c) __builtin_amdgcn_mfma_f32_16x16x32_bf16((a), (b), (c), 0, 0, 0)

struct EpiIn {
    static constexpr bool PERM = true, AFTER_DRAIN = false;
    bf16 *ug, *v, *ps, *sgb; float* ssq;
    __device__ __forceinline__ void operator()(const f32x4 (&acc)[2][2][4][2], const pg8::Unit& u, int wr, int wc, int fr, int fq) const {
        const int row0 = u.pm * 256 + wr * 64 + fr;
        if (u.pn < 8) {
            const int col0 = u.pn * 128 + wc * 32 + 8 * fq;
#pragma unroll
            for (int ai = 0; ai < 2; ++ai)
#pragma unroll
                for (int m = 0; m < 4; ++m) {
                    const size_t off = (size_t)(row0 + ai * 128 + m * 16) * D + col0;
                    float o[8];
#pragma unroll
                    for (int n = 0; n < 2; ++n)
#pragma unroll
                        for (int j = 0; j < 4; ++j) o[n * 4 + j] = gelu_t(acc[ai][0][m][n][j]) * sigmoid_f(acc[ai][1][m][n][j]);
                    u32x4 w; w.x = pk2(o[0], o[1]); w.y = pk2(o[2], o[3]); w.z = pk2(o[4], o[5]); w.w = pk2(o[6], o[7]);
                    *(u32x4*)(ug + off) = w;
                }
        } else if (u.pn < 12) {
#pragma unroll
            for (int ai = 0; ai < 2; ++ai)
#pragma unroll
                for (int m = 0; m < 4; ++m) {
                    const int row = row0 + ai * 128 + m * 16; float ss = 0.f;
#pragma unroll
                    for (int bj = 0; bj < 2; ++bj) {
                        const int col0 = (u.pn - 8) * 256 + bj * 128 + wc * 32 + 8 * fq;
                        float o[8];
#pragma unroll
                        for (int n = 0; n < 2; ++n)
#pragma unroll
                            for (int j = 0; j < 4; ++j) { const float g = gelu_t(acc[ai][bj][m][n][j]); o[n * 4 + j] = g; ss += g * g; }
                        u32x4 w; w.x = pk2(o[0], o[1]); w.y = pk2(o[2], o[3]); w.z = pk2(o[4], o[5]); w.w = pk2(o[6], o[7]);
                        *(u32x4*)(v + (size_t)row * D + col0) = w;
                    }
                    ss += __shfl_xor(ss, 16); ss += __shfl_xor(ss, 32);
                    if (fq == 0) atomicAdd(ssq + row, ss);
                }
        } else {
            const bool isS = u.pn < 16; bf16* dst = isS ? ps : sgb; const int cb = (u.pn - (isS ? 12 : 16)) * 256;
#pragma unroll
            for (int ai = 0; ai < 2; ++ai)
#pragma unroll
                for (int m = 0; m < 4; ++m)
#pragma unroll
                    for (int bj = 0; bj < 2; ++bj) {
                        const size_t off = (size_t)(row0 + ai * 128 + m * 16) * D + cb + bj * 128 + wc * 32 + 8 * fq;
                        float o[8];
#pragma unroll
                        for (int n = 0; n < 2; ++n)
#pragma unroll
                            for (int j = 0; j < 4; ++j) { const float a = acc[ai][bj][m][n][j]; o[n * 4 + j] = isS ? a : sigmoid_f(a); }
                        u32x4 w; w.x = pk2(o[0], o[1]); w.y = pk2(o[2], o[3]); w.z = pk2(o[4], o[5]); w.w = pk2(o[6], o[7]);
                        *(u32x4*)(dst + off) = w;
                    }
        }
    }
};
struct EpiGlu {
    static constexpr bool PERM = true, AFTER_DRAIN = false;
    bf16* apart; const bf16* sgb; const bf16* z; const float* bglu;
    __device__ __forceinline__ void operator()(const f32x4 (&acc)[2][2][4][2], const pg8::Unit& u, int wr, int wc, int fr, int fq) const {
        const int row0 = u.pm * 256 + wr * 64 + fr;
#pragma unroll
        for (int bj = 0; bj < 2; ++bj) {
            const int col0 = u.pn * 256 + bj * 128 + wc * 32 + 8 * fq;
            const f32x4 b0 = *(const f32x4*)(bglu + col0), b1 = *(const f32x4*)(bglu + col0 + 4);
#pragma unroll
            for (int ai = 0; ai < 2; ++ai)
#pragma unroll
                for (int m = 0; m < 4; ++m) {
                    const size_t off = (size_t)(row0 + ai * 128 + m * 16) * D + col0;
                    const u32x4 wa = *(const u32x4*)(apart + off), wg = *(const u32x4*)(sgb + off), wz = *(const u32x4*)(z + off);
                    float o[8];
#pragma unroll
                    for (int q = 0; q < 4; ++q) {
                        const float a0 = acc[ai][bj][m][q >> 1][(q & 1) * 2] + ((q >> 1) ? b1 : b0)[(q & 1) * 2];
                        const float a1 = acc[ai][bj][m][q >> 1][(q & 1) * 2 + 1] + ((q >> 1) ? b1 : b0)[(q & 1) * 2 + 1];
                        o[2 * q] = blo(wa[q]) + blo(wg[q]) * blo(wz[q]) * sigmoid_f(a0);
                        o[2 * q + 1] = bhi(wa[q]) + bhi(wg[q]) * bhi(wz[q]) * sigmoid_f(a1);
                    }
                    u32x4 w; w.x = pk2(o[0], o[1]); w.y = pk2(o[2], o[3]); w.z = pk2(o[4], o[5]); w.w = pk2(o[6], o[7]);
                    *(u32x4*)(apart + off) = w;
                }
        }
    }
};
struct EpiRes {
    static constexpr bool PERM = false, AFTER_DRAIN = false;
    const float* xold; float* xout; const float* gt;
    __device__ __forceinline__ void operator()(const f32x4 (&acc)[2][2][4][2], const pg8::Unit& u, int wr, int wc, int fr, int fq) const {
        const int row0 = u.pm * 256 + wr * 64 + fr, col0 = u.pn * 256 + wc * 32 + 4 * fq;
        const float* g = gt + (size_t)(u.pm >> 3) * NMODC;
        f32x4 gv[2][2];
#pragma unroll
        for (int bj = 0; bj < 2; ++bj)
#pragma unroll
            for (int n = 0; n < 2; ++n) gv[bj][n] = *(const f32x4*)(g + col0 + bj * 128 + n * 16);
#pragma unroll
        for (int ai = 0; ai < 2; ++ai)
#pragma unroll
            for (int m = 0; m < 4; ++m) {
                const size_t off = (size_t)(row0 + ai * 128 + m * 16) * D + col0;
#pragma unroll
                for (int bj = 0; bj < 2; ++bj)
#pragma unroll
                    for (int n = 0; n < 2; ++n) {
                        const f32x4 xo = *(const f32x4*)(xold + off + bj * 128 + n * 16);
                        *(f32x4*)(xout + off + bj * 128 + n * 16) = xo + gv[bj][n] * acc[ai][bj][m][n];
                    }
            }
    }
};
struct EpiFF1 {
    static constexpr bool PERM = true, AFTER_DRAIN = false;
    bf16* act;
    __device__ __forceinline__ void operator()(const f32x4 (&acc)[2][2][4][2], const pg8::Unit& u, int wr, int wc, int fr, int fq) const {
        const int row0 = u.pm * 256 + wr * 64 + fr;
#pragma unroll
        for (int ai = 0; ai < 2; ++ai)
#pragma unroll
            for (int m = 0; m < 4; ++m)
#pragma unroll
                for (int bj = 0; bj < 2; ++bj) {
                    const size_t off = (size_t)(row0 + ai * 128 + m * 16) * FF + u.pn * 256 + bj * 128 + wc * 32 + 8 * fq;
                    float o[8];
#pragma unroll
                    for (int n = 0; n < 2; ++n)
#pragma unroll
                        for (int j = 0; j < 4; ++j) { const float a = fmaxf(acc[ai][bj][m][n][j], 0.f); o[n * 4 + j] = a * a; }
                    u32x4 w; w.x = pk2(o[0], o[1]); w.y = pk2(o[2], o[3]); w.z = pk2(o[4], o[5]); w.w = pk2(o[6], o[7]);
                    *(u32x4*)(act + off) = w;
                }
    }
};

template <int MB, class Epi>
__device__ __forceinline__ void small_gemm(unsigned char* lds, const bf16* A, const bf16* Bt, int N, int K, const Epi& E, int wave, int lane) {
    const int tid = otid(); lane = tid & 63; wave = __builtin_amdgcn_readfirstlane(tid >> 6);
    const int fr = lane & 15, fq = lane >> 4;
    f32x4* red = (f32x4*)lds;
    const int kw = K >> 3;
    for (int nb = blockIdx.x; nb < (N >> 4); nb += gridDim.x) {
        f32x4 acc[MB];
#pragma unroll
        for (int mb = 0; mb < MB; ++mb) acc[mb] = (f32x4){0.f, 0.f, 0.f, 0.f};
        const bf16* bp = Bt + (size_t)(nb * 16 + fr) * K + wave * kw + fq * 8;
        const bf16* ap = A + (size_t)fr * K + wave * kw + fq * 8;
#pragma unroll 2
        for (int ks = 0; ks < kw; ks += 32) {
            const bf16x8 b = *(const bf16x8*)(bp + ks);
#pragma unroll
            for (int mb = 0; mb < MB; ++mb) { const bf16x8 a = *(const bf16x8*)(ap + (size_t)mb * 16 * K + ks); acc[mb] = MFMA16(b, a, acc[mb]); }
        }
#pragma unroll
        for (int mb = 0; mb < MB; ++mb) red[(wave * MB + mb) * 64 + lane] = acc[mb];
        __syncthreads();
        for (int e = tid; e < MB * 64; e += 512) {
            const int mb = e >> 6, ln = e & 63; f32x4 s = red[mb * 64 + ln];
#pragma unroll
            for (int w = 1; w < 8; ++w) s += red[(w * MB + mb) * 64 + ln];
            E(mb * 16 + (ln & 15), nb * 16 + (ln >> 4) * 4, s);
        }
        __syncthreads();
    }
}
struct SEpiAda { float* mod; const float* bias;
    __device__ __forceinline__ void operator()(int row, int col, f32x4 v) const { if (row < NMODR) *(f32x4*)(mod + (size_t)row * NMODC + col) = v + *(const f32x4*)(bias + col); } };
struct SEpiIn { float *gu, *sga, *gv, *ps, *sgb;
    __device__ __forceinline__ void operator()(int row, int col, f32x4 v) const {
        if (col < 2048) { const int tile = col >> 8, w = col & 255;
            if (w < 128) { f32x4 o; for (int j = 0; j < 4; ++j) o[j] = gelu_t(v[j]); *(f32x4*)(gu + (size_t)row * D + tile * 128 + w) = o; }
            else { f32x4 o; for (int j = 0; j < 4; ++j) o[j] = sigmoid_f(v[j]); *(f32x4*)(sga + (size_t)row * D + tile * 128 + w - 128) = o; } }
        else if (col < 3072) { f32x4 o; for (int j = 0; j < 4; ++j) o[j] = gelu_t(v[j]); *(f32x4*)(gv + (size_t)row * D + col - 2048) = o; }
        else if (col < 4096) { *(f32x4*)(ps + (size_t)row * D + col - 3072) = v; }
        else { f32x4 o; for (int j = 0; j < 4; ++j) o[j] = sigmoid_f(v[j]); *(f32x4*)(sgb + (size_t)row * D + col - 4096) = o; }
    } };
struct SEpiGlu { const float* apart; const float* sgb; const bf16* z; const float* bglu; bf16* merged;
    __device__ __forceinline__ void operator()(int row, int col, f32x4 v) const {
        const size_t off = (size_t)row * D + col; const u32x2 wz = *(const u32x2*)(z + off); const f32x4 a = *(const f32x4*)(apart + off), g = *(const f32x4*)(sgb + off), b = *(const f32x4*)(bglu + col);
        const float o0 = a[0] + g[0] * blo(wz.x) * sigmoid_f(v[0] + b[0]), o1 = a[1] + g[1] * bhi(wz.x) * sigmoid_f(v[1] + b[1]);
        const float o2 = a[2] + g[2] * blo(wz.y) * sigmoid_f(v[2] + b[2]), o3 = a[3] + g[3] * bhi(wz.y) * sigmoid_f(v[3] + b[3]);
        u32x2 w; w.x = pk2(o0, o1); w.y = pk2(o2, o3); *(u32x2*)(merged + off) = w;
    } };
struct SEpiRes { const float* xold; float* xout; const float* gt;
    __device__ __forceinline__ void operator()(int row, int col, f32x4 v) const {
        const size_t off = (size_t)row * D + col; *(f32x4*)(xout + off) = *(const f32x4*)(xold + off) + *(const f32x4*)(gt + (size_t)row * NMODC + col) * v; } };
struct SEpiFF1 { bf16* act;
    __device__ __forceinline__ void operator()(int row, int col, f32x4 v) const {
        float o[4]; for (int j = 0; j < 4; ++j) { const float a = fmaxf(v[j], 0.f); o[j] = a * a; }
        u32x2 w; w.x = pk2(o[0], o[1]); w.y = pk2(o[2], o[3]); *(u32x2*)(act + (size_t)row * FF + col) = w; } };

__device__ __forceinline__ void transpose_item(const float* W, int K, int N, bf16* WT, int k0, int n0, int drow0, float* scr, int lane) {
#pragma unroll 8
    for (int i = 0; i < 32; ++i) { const int kk = 2 * i + (lane >> 5); scr[kk * 33 + (lane & 31)] = W[(size_t)(k0 + kk) * N + n0 + (lane & 31)]; }
    LDS_FENCE();
    const int c = lane & 7;
#pragma unroll
    for (int j = 0; j < 4; ++j) { const int n = (lane >> 3) + 8 * j; const float* s = scr + (8 * c) * 33 + n;
        u32x4 o; o.x = pk2(s[0 * 33], s[1 * 33]); o.y = pk2(s[2 * 33], s[3 * 33]); o.z = pk2(s[4 * 33], s[5 * 33]); o.w = pk2(s[6 * 33], s[7 * 33]);
        *(u32x4*)(WT + (size_t)(drow0 + n) * K + k0 + 8 * c) = o; }
    LDS_FENCE();
}
__device__ __forceinline__ int perm_in(int n) {
    if (n < 1024) return ((n >> 7) << 8) + (n & 127);
    if (n < 3072) return n + 1024;
    if (n < 4096) { const int m = n - 3072; return ((m >> 7) << 8) + 128 + (m & 127); }
    return n;
}
__device__ __forceinline__ float2 cmul(float2 a, float2 b) { return make_float2(a.x * b.x - a.y * b.y, a.x * b.y + a.y * b.x); }

__device__ __forceinline__ void prep_layer(const Params& P, int l, unsigned char* lds, int wave, int lane) {
    const int tid = otid(); lane = tid & 63; wave = __builtin_amdgcn_readfirstlane(tid >> 6);
    unsigned char* ws = P.ws;
    float2* apow = (float2*)lds;
    float2* Bb = (float2*)(lds + 16896);
    float2* Cc = (float2*)(lds + 16896 + 8192);
    bf16* ktab = (bf16*)(ws + WS_KTAB); bf16* WS_ = (bf16*)(ws + WS_WS); bf16* WY_ = (bf16*)(ws + WS_WY);
    float2* abar_f = (float2*)(ws + WS_S5F); float2* aT_f = abar_f + 4096; float2* bbar_f = abar_f + 8192;
    for (int wt = blockIdx.x; wt < 256; wt += gridDim.x) {
        const int g = wt >> 2, q = wt & 3, lg = l * 64 + g;
        const float dt = __expf(P.in[I_LDT][lg]);
        for (int e = tid; e < 33 * 64; e += 512) {
            const int tau = e >> 6, p = e & 63; const float lr = P.in[I_LRE][lg * 64 + p], li = P.in[I_LIM][lg * 64 + p];
            const float mag = __expf(lr * dt * (float)tau); float tr = li * dt * (float)tau * 0.15915494309f; tr -= rintf(tr);
            apow[e] = make_float2(mag * __builtin_amdgcn_cosf(tr), mag * __builtin_amdgcn_sinf(tr));
        }
        for (int e = tid; e < 1024; e += 512) {
            const int p = e >> 4, hh = e & 15; const float lr = P.in[I_LRE][lg * 64 + p], li = P.in[I_LIM][lg * 64 + p];
            const float x = lr * dt; const float em1 = (fabsf(x) < 0.1f) ? x * (1.f + x * (0.5f + x * (0.16666667f + x * (0.041666667f + x * 0.0083333333f)))) : (__expf(x) - 1.f);
            float tr = li * dt * 0.15915494309f; tr -= rintf(tr);
            const float cs = __builtin_amdgcn_cosf(tr), sn = __builtin_amdgcn_sinf(tr), sh = __builtin_amdgcn_sinf(tr * 0.5f);
            const float ar1 = em1 * cs - 2.f * sh * sh, ai = (em1 + 1.f) * sn;
            const float inv = 1.f / (lr * lr + li * li);
            const float2 coef = make_float2((ar1 * lr + ai * li) * inv, (ai * lr - ar1 * li) * inv);
            const size_t bi = ((size_t)lg * 64 + p) * 16 + hh;
            Bb[e] = cmul(coef, make_float2(P.in[I_BRE][bi], P.in[I_BIM][bi]));
            const int h2 = e >> 6, p2 = e & 63; const size_t ci = ((size_t)lg * 16 + h2) * 64 + p2;
            Cc[e] = make_float2(P.in[I_CRE][ci], P.in[I_CIM][ci]);
        }
        __syncthreads();
        if (q == 0) {
            for (int e = tid; e < 64; e += 512) { abar_f[g * 64 + e] = apow[64 + e]; aT_f[g * 64 + e] = apow[32 * 64 + e]; }
            for (int e = tid; e < 1024; e += 512) bbar_f[g * 1024 + e] = Bb[e];
            for (int e = tid; e < 256; e += 512) ktab[(size_t)(g * 33) * 256 + e] = 0;
        }
        for (int e = tid; e < 8 * 256; e += 512) {
            const int ti = q * 8 + 1 + (e >> 8), tau = ti - 1, h = (e >> 4) & 15, hh = e & 15; float s = 0.f;
            for (int p = 0; p < 64; ++p) { const float2 ca = cmul(Cc[h * 64 + p], apow[tau * 64 + p]); const float2 b = Bb[p * 16 + hh]; s += ca.x * b.x - ca.y * b.y; }
            ktab[(size_t)(g * 33 + ti) * 256 + (e & 255)] = (bf16)f2bf(s);
        }
        for (int e = tid; e < 32 * 512; e += 512) {
            const int n = 32 * q + (e >> 9), k = e & 511, p = n >> 1, s = k >> 4, hh = k & 15;
            const float2 v = cmul(apow[(31 - s) * 64 + p], Bb[p * 16 + hh]);
            WS_[((size_t)g * 128 + n) * 512 + k] = (bf16)f2bf((n & 1) ? v.y : v.x);
        }
        for (int e = tid; e < 128 * 128; e += 512) {
            const int row = 128 * q + (e >> 7), k = e & 127, t = row >> 4, h = row & 15, p = k >> 1;
            const float2 ca = cmul(Cc[h * 64 + p], apow[(t + 1) * 64 + p]);
            WY_[((size_t)g * 512 + row) * 128 + k] = (bf16)f2bf((k & 1) ? -ca.y : ca.x);
        }
        __syncthreads();
    }
    float* scr = (float*)(lds + wave * 8448);
    const int gw = blockIdx.x * 8 + wave, NGW = gridDim.x * 8;
    const float* w_in = P.in[I_WIN] + (size_t)l * D * NIN; const float* w_glu = P.in[I_WGLU] + (size_t)l * D * D; const float* w_out = P.in[I_WOUT] + (size_t)l * D * D;
    const float* w_ff1 = P.in[I_WFF1] + (size_t)l * D * FF; const float* w_ff2 = P.in[I_WFF2] + (size_t)l * FF * D;
    constexpr int IT_IN = 16 * 160, IT_G = 16 * 32, IT_F1 = 16 * 128, IT_F2 = 64 * 32, IT_ALL = IT_IN + 2 * IT_G + IT_F1 + IT_F2;
    for (int it = gw; it < IT_ALL; it += NGW) {
        int r = it;
        if (r < IT_IN) { const int kb = r / 160, nb = r % 160; transpose_item(w_in, D, NIN, (bf16*)(ws + WS_WIN), kb * 64, nb * 32, perm_in(nb * 32), scr, lane); continue; } r -= IT_IN;
        if (r < IT_G) { const int kb = r / 32, nb = r % 32; transpose_item(w_glu, D, D, (bf16*)(ws + WS_WGLU), kb * 64, nb * 32, nb * 32, scr, lane); continue; } r -= IT_G;
        if (r < IT_G) { const int kb = r / 32, nb = r % 32; transpose_item(w_out, D, D, (bf16*)(ws + WS_WOUT), kb * 64, nb * 32, nb * 32, scr, lane); continue; } r -= IT_G;
        if (r < IT_F1) { const int kb = r / 128, nb = r % 128; transpose_item(w_ff1, D, FF, (bf16*)(ws + WS_WFF1), kb * 64, nb * 32, nb * 32, scr, lane); continue; } r -= IT_F1;
        { const int kb = r / 32, nb = r % 32; transpose_item(w_ff2, FF, D, (bf16*)(ws + WS_WFF2), kb * 64, nb * 32, nb * 32, scr, lane); }
    }
}
__device__ __forceinline__ void prep_misc(const Params& P, unsigned char* lds, int wave, int lane) {
    unsigned char* ws = P.ws;
    const int tid = otid(); lane = tid & 63; wave = __builtin_amdgcn_readfirstlane(tid >> 6);
    float* scr = (float*)(lds + wave * 8448);
    const int gw = blockIdx.x * 8 + wave, NGW = gridDim.x * 8;
    constexpr int IT_A = 16 * 192;
    for (int it = gw; it < 2 * IT_A; it += NGW) {
        const int l = it / IT_A, r = it % IT_A, kb = r / 192, nb = r % 192;
        transpose_item(P.in[I_WADA] + (size_t)l * D * NMODC, D, NMODC, (bf16*)(ws + WS_B1) + (size_t)l * NMODC * D, kb * 64, nb * 32, nb * 32, scr, lane);
    }
    const int gt = blockIdx.x * 512 + tid, NGT = gridDim.x * 512;
    bf16* cs = (bf16*)(ws + WS_CSILU);
    for (int e = gt; e < 144 * D; e += NGT) {
        const int r = e >> 10, c = e & 1023; float x = 0.f;
        if (r < 128) x = P.in[I_CS][r * D + c]; else if (r < 136) x = P.in[I_CP][(r - 128) * D + c];
        cs[e] = (bf16)f2bf(x * sigmoid_f(x));
    }
    bf16* wsb = (bf16*)(ws + WS_WSB);
    for (int e = gt; e < 2 * 4 * 128 * 128; e += NGT) { const int s = e & 127, t = (e >> 7) & 127; wsb[e] = (bf16)f2bf(s <= t ? P.in[I_WSP][e] : 0.f); }
}

__device__ __forceinline__ void norm_phase(const Params& P, int l, const float* xP, const float* xS, const float* gn, int shoff, int scoff, int wave, int lane) {
    { const int tid = otid(); lane = tid & 63; wave = __builtin_amdgcn_readfirstlane(tid >> 6); }
    const int gw = blockIdx.x * 8 + wave, NGW = gridDim.x * 8;
    bf16* hb = (bf16*)(P.ws + WS_B0);
    const float* mod = (const float*)(P.ws + WS_MOD) + (size_t)l * NMODR * NMODC;
    for (int r = gw; r < NR; r += NGW) {
        const float* xr = (r < NP) ? xP + (size_t)r * D : xS + (size_t)(r - NP) * D;
        const float* mr = mod + (size_t)((r < NP) ? 128 + (r >> 11) : r - NP) * NMODC;
        f32x4 v[4]; float ss = 0.f;
#pragma unroll
        for (int j = 0; j < 4; ++j) { v[j] = *(const f32x4*)(xr + (lane + 64 * j) * 4); ss += (v[j].x * v[j].x + v[j].y * v[j].y) + (v[j].z * v[j].z + v[j].w * v[j].w); }
        const float rstd = rsqrtf(wave_sum(ss) * (1.f / D) + EPS);
#pragma unroll
        for (int j = 0; j < 4; ++j) {
            const int c = (lane + 64 * j) * 4;
            const f32x4 g = *(const f32x4*)(gn + c), sc = *(const f32x4*)(mr + scoff + c), sh = *(const f32x4*)(mr + shoff + c);
            const f32x4 o = v[j] * rstd * g * (1.f + sc) + sh;
            u32x2 w; w.x = pk2(o.x, o.y); w.y = pk2(o.z, o.w); *(u32x2*)(hb + (size_t)r * D + c) = w;
        }
    }
}
__device__ __forceinline__ void final_norm(const Params& P, int wave, int lane) {
    { const int tid = otid(); lane = tid & 63; wave = __builtin_amdgcn_readfirstlane(tid >> 6); }
    const int gw = blockIdx.x * 8 + wave, NGW = gridDim.x * 8;
    for (int r = gw; r < NR; r += NGW) {
        float* xr = P.out + (size_t)r * D;
        f32x4 v[4]; float ss = 0.f;
#pragma unroll
        for (int j = 0; j < 4; ++j) { v[j] = *(const f32x4*)(xr + (lane + 64 * j) * 4); ss += (v[j].x * v[j].x + v[j].y * v[j].y) + (v[j].z * v[j].z + v[j].w * v[j].w); }
        const float rstd = rsqrtf(wave_sum(ss) * (1.f / D) + EPS);
#pragma unroll
        for (int j = 0; j < 4; ++j) { const int c = (lane + 64 * j) * 4; *(f32x4*)(xr + c) = v[j] * rstd * *(const f32x4*)(P.in[I_GFIN] + c); }
    }
}

__device__ __forceinline__ void mix_phase(const Params& P, int l, unsigned char* lds, int wave, int lane) {
    const int tid = otid(); lane = tid & 63; wave = __builtin_amdgcn_readfirstlane(tid >> 6);
    const int fr = lane & 15, fq = lane >> 4;
    unsigned char* ws = P.ws;
    bf16* ug = (bf16*)(ws + WS_B1); const bf16* vb = (const bf16*)(ws + WS_B2); const float* ssq = (const float*)(ws + WS_SSQ);
    const float* gv = P.in[I_GV] + l * D; const float* bsp = P.in[I_BSP] + l * 512; const bf16* wsb = (const bf16*)(ws + WS_WSB) + (size_t)l * 4 * 128 * 128;
    bf16* vt = (bf16*)lds;
    for (int wt = blockIdx.x; wt < 2048; wt += gridDim.x) {
        const int dsub = wt & 3, h = (wt >> 2) & 3, cc = wt >> 4, tok0 = cc * 128, cb = h * 256 + dsub * 64;
        {
            const int s = tid >> 2, dq = tid & 3;
            const float r = rsqrtf(ssq[tok0 + s] * (1.f / D) + EPS);
            const bf16* src = vb + (size_t)(tok0 + s) * D + cb + dq * 16;
            const u32x4 a = *(const u32x4*)src, b = *(const u32x4*)(src + 8);
            const float* gp = gv + cb + dq * 16;
            bf16* dst = vt + (dq * 16) * 136 + s;
#pragma unroll
            for (int j = 0; j < 4; ++j) {
                dst[(2 * j) * 136] = (bf16)f2bf(blo(a[j]) * r * gp[2 * j]); dst[(2 * j + 1) * 136] = (bf16)f2bf(bhi(a[j]) * r * gp[2 * j + 1]);
                dst[(8 + 2 * j) * 136] = (bf16)f2bf(blo(b[j]) * r * gp[8 + 2 * j]); dst[(9 + 2 * j) * 136] = (bf16)f2bf(bhi(b[j]) * r * gp[9 + 2 * j]);
            }
        }
        __syncthreads();
        f32x4 acc[4];
#pragma unroll
        for (int ib = 0; ib < 4; ++ib) acc[ib] = (f32x4){0.f, 0.f, 0.f, 0.f};
        const int nks = (wave >> 1) + 1;
        const bf16* wrow = wsb + ((size_t)(h * 128 + wave * 16 + fr)) * 128 + fq * 8;
#pragma unroll
        for (int ks = 0; ks < 4; ++ks) if (ks < nks) {
            const bf16x8 yf = *(const bf16x8*)(wrow + ks * 32);
#pragma unroll
            for (int ib = 0; ib < 4; ++ib) { const bf16x8 xf = *(const bf16x8*)(vt + (ib * 16 + fr) * 136 + ks * 32 + fq * 8); acc[ib] = MFMA16(xf, yf, acc[ib]); }
        }
        const int t = wave * 16 + fr; const float bias = bsp[h * 128 + t];
#pragma unroll
        for (int ib = 0; ib < 4; ++ib) {
            const size_t off = (size_t)(tok0 + t) * D + cb + ib * 16 + fq * 4;
            const u32x2 w = *(const u32x2*)(ug + off);
            u32x2 o; o.x = pk2(blo(w.x) * (acc[ib][0] + bias), bhi(w.x) * (acc[ib][1] + bias)); o.y = pk2(blo(w.y) * (acc[ib][2] + bias), bhi(w.y) * (acc[ib][3] + bias));
            *(u32x2*)(ug + off) = o;
        }
        __syncthreads();
    }
}
__device__ __forceinline__ void s5_chunk_sums(const Params& P, int wave, int lane) {
    { const int tid = otid(); lane = tid & 63; wave = __builtin_amdgcn_readfirstlane(tid >> 6); }
    const int fr = lane & 15, fq = lane >> 4;
    const int gw = blockIdx.x * 8 + wave, NGW = gridDim.x * 8;
    const bf16* ps = (const bf16*)(P.ws + WS_B3); const bf16* WS_ = (const bf16*)(P.ws + WS_WS); float* Sc = (float*)(P.ws + WS_SC);
    for (int wt = gw; wt < 1024; wt += NGW) {
        const int g = wt & 63, mt2 = wt >> 6, rA = mt2 * 32 + fr, rB = rA + 16;
        f32x4 acc[2][8];
#pragma unroll
        for (int i = 0; i < 2; ++i)
#pragma unroll
            for (int nb = 0; nb < 8; ++nb) acc[i][nb] = (f32x4){0.f, 0.f, 0.f, 0.f};
        const bf16* pa = ps + ((size_t)rA * 32 + (fq >> 1)) * D + g * 16 + (fq & 1) * 8;
        const bf16* pb = ps + ((size_t)rB * 32 + (fq >> 1)) * D + g * 16 + (fq & 1) * 8;
        const bf16* pw = WS_ + ((size_t)g * 128 + fr) * 512 + fq * 8;
#pragma unroll 2
        for (int ks = 0; ks < 16; ++ks) {
            const bf16x8 ya = *(const bf16x8*)(pa + (size_t)ks * 2 * D), yb = *(const bf16x8*)(pb + (size_t)ks * 2 * D);
#pragma unroll
            for (int nb = 0; nb < 8; ++nb) { const bf16x8 xw = *(const bf16x8*)(pw + (size_t)nb * 16 * 512 + ks * 32); acc[0][nb] = MFMA16(xw, ya, acc[0][nb]); acc[1][nb] = MFMA16(xw, yb, acc[1][nb]); }
        }
#pragma unroll
        for (int nb = 0; nb < 8; ++nb) {
            *(f32x4*)(Sc + ((size_t)rA * 64 + g) * 128 + nb * 16 + fq * 4) = acc[0][nb];
            *(f32x4*)(Sc + ((size_t)rB * 64 + g) * 128 + nb * 16 + fq * 4) = acc[1][nb];
        }
    }
}
__device__ __forceinline__ void sample_mix(const Params& P, int l, unsigned char* lds, int wave, int lane) {
    { const int tid = otid(); lane = tid & 63; wave = __builtin_amdgcn_readfirstlane(tid >> 6); }
    const int gw = blockIdx.x * 8 + wave, NGW = gridDim.x * 8;
    unsigned char* ws = P.ws;
    const float* s_gu = (const float*)(ws + WS_SMALL); const float* s_sga = s_gu + NS * D; const float* s_gv = s_sga + NS * D; const float* s_ps = s_gv + NS * D;
    float* s_apart = (float*)(ws + WS_SMALL) + 5 * NS * D;
    for (int i = gw; i < NS; i += NGW) {
        f32x4 v[4]; float ss = 0.f;
#pragma unroll
        for (int j = 0; j < 4; ++j) { v[j] = *(const f32x4*)(s_gv + (size_t)i * D + (lane + 64 * j) * 4); ss += (v[j].x * v[j].x + v[j].y * v[j].y) + (v[j].z * v[j].z + v[j].w * v[j].w); }
        const float r = rsqrtf(wave_sum(ss) * (1.f / D) + EPS);
#pragma unroll
        for (int j = 0; j < 4; ++j) {
            const int d = (lane + 64 * j) * 4, h = d >> 8;
            const f32x4 vn = v[j] * r * *(const f32x4*)(P.in[I_GV] + l * D + d);
            *(f32x4*)(P.out + O_V + ((size_t)l * NS + i) * D + d) = vn;
            const float w00 = P.in[I_WSP][(size_t)(l * 4 + h) * 128 * 128], b0 = P.in[I_BSP][(l * 4 + h) * 128];
            const f32x4 mixed = vn * w00 + b0;
            *(f32x4*)(s_apart + (size_t)i * D + d) = *(const f32x4*)(s_gu + (size_t)i * D + d) * *(const f32x4*)(s_sga + (size_t)i * D + d) * mixed;
        }
    }
    const float2* abar_f = (const float2*)(ws + WS_S5F); const float2* bbar_f = abar_f + 8192;
    bf16* zs = (bf16*)(ws + WS_B0) + (size_t)NP * D;
    float* sw = (float*)(lds + wave * 512);
    for (int wt = gw; wt < NS * 64; wt += NGW) {
        const int i = wt >> 6, g = wt & 63, p = lane;
        const float* xs = s_ps + (size_t)i * D + g * 16;
        float xr[16];
#pragma unroll
        for (int j = 0; j < 4; ++j) { const f32x4 t = *(const f32x4*)(xs + 4 * j); xr[4 * j] = t.x; xr[4 * j + 1] = t.y; xr[4 * j + 2] = t.z; xr[4 * j + 3] = t.w; }
        const float2* bb = bbar_f + ((size_t)g * 64 + p) * 16;
        float bur = 0.f, bui = 0.f;
#pragma unroll
        for (int k = 0; k < 16; ++k) { const float2 b = bb[k]; bur += b.x * xr[k]; bui += b.y * xr[k]; }
        const float2 a = abar_f[g * 64 + p];
        const size_t si = (((size_t)l * NS + i) * 64 + g) * 64 + p;
        const float h0r = P.in[I_SRE][si], h0i = P.in[I_SIM][si];
        const float hr = a.x * h0r - a.y * h0i + bur, hi = a.x * h0i + a.y * h0r + bui;
        P.out[O_RS + si] = hr; P.out[O_IS + si] = hi;
        sw[p] = hr; sw[64 + p] = hi;
        LDS_FENCE();
        const int h = lane & 15, part = lane >> 4;
        const float* cr = P.in[I_CRE] + (((size_t)l * 64 + g) * 16 + h) * 64 + part * 16; const float* ci = P.in[I_CIM] + (((size_t)l * 64 + g) * 16 + h) * 64 + part * 16;
        float s = 0.f;
#pragma unroll
        for (int k = 0; k < 16; ++k) s += cr[k] * sw[part * 16 + k] - ci[k] * sw[64 + part * 16 + k];
        s += __shfl_xor(s, 16); s += __shfl_xor(s, 32);
        if (part == 0) { const float y = s + P.in[I_DSK][l * D + g * 16 + h] * xs[h]; zs[(size_t)i * D + g * 16 + h] = (bf16)f2bf(gelu_t(y)); }
        LDS_FENCE();
    }
}
__device__ __forceinline__ void s5_scan(const Params& P, int l) {
    const int gt = blockIdx.x * 512 + otid();
    if (gt >= 8 * 64 * 64) return;
    const int p = gt & 63, g = (gt >> 6) & 63, b = gt >> 12;
    const float2 aT = ((const float2*)(P.ws + WS_S5F))[4096 + g * 64 + p];
    const float* Sc = (const float*)(P.ws + WS_SC); unsigned* Hin = (unsigned*)(P.ws + WS_HIN);
    float hr = 0.f, hi = 0.f;
    for (int c0 = 0; c0 < 64; c0 += 8) {
        float2 s[8];
#pragma unroll
        for (int j = 0; j < 8; ++j) s[j] = *(const float2*)(Sc + (((size_t)(b * 64 + c0 + j)) * 64 + g) * 128 + 2 * p);
#pragma unroll
        for (int j = 0; j < 8; ++j) {
            Hin[(((size_t)(b * 64 + c0 + j)) * 64 + g) * 64 + p] = pk2(hr, hi);
            const float nr = aT.x * hr - aT.y * hi + s[j].x, ni = aT.x * hi + aT.y * hr + s[j].y; hr = nr; hi = ni;
        }
    }
    const size_t oi = (((size_t)l * 8 + b) * 64 + g) * 64 + p;
    P.out[O_RP + oi] = hr; P.out[O_IP + oi] = hi;
}
template <int TH>
__device__ __forceinline__ void s5_out_half(const unsigned char* lwy, const unsigned char* lkt, const bf16* ps, const bf16* Hin, bf16* zb, const float* dskp, int R, int g, int fr, int fq) {
    constexpr int NT = 8, T0 = TH * NT, NX = 4 * (TH + 1);
    bf16x8 xf[NX];
    const bf16* px = ps + ((size_t)R * 32 + (fq >> 1)) * D + g * 16 + (fq & 1) * 8;
#pragma unroll
    for (int i = 0; i < NX; ++i) xf[i] = *(const bf16x8*)(px + (size_t)i * 2 * D);
    f32x4 acc[NT];
#pragma unroll
    for (int t = 0; t < NT; ++t) acc[t] = (f32x4){0.f, 0.f, 0.f, 0.f};
    {
        bf16x8 hf[4];
#pragma unroll
        for (int k = 0; k < 4; ++k) hf[k] = *(const bf16x8*)(Hin + ((size_t)R * 64 + g) * 128 + k * 32 + fq * 8);
#pragma unroll
        for (int t = 0; t < NT; ++t)
        {
#pragma unroll
            for (int k = 0; k < 4; ++k) { const int row = (T0 + t) * 16 + fr; const bf16x8 xw = *(const bf16x8*)(lwy + row * 256 + (((k * 4 + fq) ^ fr) << 4)); acc[t] = MFMA16(xw, hf[k], acc[t]); }
            if ((t & 3) == 3) __builtin_amdgcn_sched_barrier(0);
        }
    }
#pragma unroll
    for (int dl = 0; dl < 32; ++dl) {
        const bf16x8 xk = *(const bf16x8*)(lkt + ((dl + 1 - (fq >> 1)) * 256 + fr * 16 + (fq & 1) * 8) * 2);
#pragma unroll
        for (int i = 0; i < NX; ++i) if (2 * i + dl >= T0 && 2 * i + dl < T0 + NT) acc[2 * i + dl - T0] = MFMA16(xk, xf[i], acc[2 * i + dl - T0]);
        if ((dl & 3) == 3) __builtin_amdgcn_sched_barrier(0);
    }
    const f32x4 dsk = *(const f32x4*)(dskp + g * 16 + fq * 4);
#pragma unroll
    for (int t = 0; t < NT; ++t) {
        const size_t off = ((size_t)R * 32 + T0 + t) * D + g * 16 + fq * 4;
        const u32x2 w = *(const u32x2*)(ps + off);
        u32x2 o; o.x = pk2(gelu_t(acc[t][0] + dsk[0] * blo(w.x)), gelu_t(acc[t][1] + dsk[1] * bhi(w.x)));
        o.y = pk2(gelu_t(acc[t][2] + dsk[2] * blo(w.y)), gelu_t(acc[t][3] + dsk[3] * bhi(w.y)));
        *(u32x2*)(zb + off) = o;
    }
}
__device__ __forceinline__ void s5_output(const Params& P, int l, unsigned char* lds, int wave, int lane) {
    const int tid = otid(); lane = tid & 63; wave = __builtin_amdgcn_readfirstlane(tid >> 6);
    const int fr = lane & 15, fq = lane >> 4;
    unsigned char* ws = P.ws;
    const bf16* ps = (const bf16*)(ws + WS_B3); const bf16* Hin = (const bf16*)(ws + WS_HIN); bf16* zb = (bf16*)(ws + WS_B0);
    const bf16* WY_ = (const bf16*)(ws + WS_WY); const bf16* ktab = (const bf16*)(ws + WS_KTAB);
    unsigned char* lwy = lds; unsigned char* lkt = lds + 131072;
    for (int wt = blockIdx.x; wt < 256; wt += gridDim.x) {
        const int g = wt >> 2, q = wt & 3;
#pragma unroll 4
        for (int i = 0; i < 16; ++i) { const int e = tid + i * 512, row = e >> 4, ch = e & 15;
            *(u32x4*)(lwy + row * 256 + ((ch ^ (row & 15)) << 4)) = *(const u32x4*)(WY_ + ((size_t)g * 512 + row) * 128 + ch * 8); }
        for (int e = tid; e < 1056; e += 512) *(u32x4*)(lkt + e * 16) = *(const u32x4*)(ktab + (size_t)g * 33 * 256 + e * 8);
        const int R = (q * 8 + wave) * 16 + fr;
        __syncthreads();
        s5_out_half<0>(lwy, lkt, ps, Hin, zb, P.in[I_DSK] + l * D, R, g, fr, fq);
        s5_out_half<1>(lwy, lkt, ps, Hin, zb, P.in[I_DSK] + l * D, R, g, fr, fq);
        s5_out_half<2>(lwy, lkt, ps, Hin, zb, P.in[I_DSK] + l * D, R, g, fr, fq);
        s5_out_half<3>(lwy, lkt, ps, Hin, zb, P.in[I_DSK] + l * D, R, g, fr, fq);
        __syncthreads();
    }
}

#define GEMM_PHASE(EpiT, Aptr, Btptr, M_, N_, K_, Eobj) do { pg8::Gemm g_{(const pg8::bf16_t*)(Aptr), (const pg8::bf16_t*)(Btptr), (M_), (N_), (K_)}; pg8::StaticOrder S_; S_.init((M_), (N_), (int)gridDim.x, (int)blockIdx.x); \
    pg8::gemm_phase<EpiT, pg8::StaticOrder, true, true>((PG8_LAS unsigned char*)lds, g_, S_, (Eobj)); } while (0)

__global__ void __launch_bounds__(512, 2) fwd_kernel(Params P) {
    extern __shared__ __attribute__((aligned(16))) unsigned char lds[];
    cg::grid_group grid = cg::this_grid();
    int lane = 0, wave = 0;
    unsigned char* ws = P.ws;
    float* xcur = P.out;
    bf16* B0 = (bf16*)(ws + WS_B0); bf16* B1 = (bf16*)(ws + WS_B1); bf16* B2 = (bf16*)(ws + WS_B2); bf16* B3 = (bf16*)(ws + WS_B3); bf16* B4 = (bf16*)(ws + WS_B4);
    float* modb = (float*)(ws + WS_MOD);
    float* sm = (float*)(ws + WS_SMALL);

    prep_misc(P, lds, wave, lane);
    __syncthreads();
    prep_layer(P, 0, lds, wave, lane);
    grid.sync();
#pragma unroll 1
    for (int l = 0; l < 2; ++l) {
        SEpiAda E{modb + (size_t)l * NMODR * NMODC, P.in[I_BADA] + (size_t)l * NMODC};
        small_gemm<9>(lds, (const bf16*)(ws + WS_CSILU), B1 + (size_t)l * NMODC * D, NMODC, D, E, wave, lane);
    }
    grid.sync();

#pragma unroll 1
    for (int l = 0; l < 2; ++l) {
        const float* xP = l ? xcur : P.in[I_XP]; const float* xS = l ? xcur + (size_t)NP * D : P.in[I_XS];
        const float* modl = modb + (size_t)l * NMODR * NMODC;
        if (l == 1) { prep_layer(P, 1, lds, wave, lane); }
        { float* ssq = (float*)(ws + WS_SSQ); for (int e = blockIdx.x * 512 + otid(); e < NP; e += gridDim.x * 512) ssq[e] = 0.f; }
        norm_phase(P, l, xP, xS, P.in[I_G1] + l * D, 0, 1024, wave, lane);
        grid.sync();
        { EpiIn E{B1, B2, B3, B4, (float*)(ws + WS_SSQ)}; GEMM_PHASE(EpiIn, B0, ws + WS_WIN, NP, NIN, D, E); }
        { SEpiIn E{sm, sm + NS * D, sm + 2 * NS * D, sm + 3 * NS * D, sm + 4 * NS * D};
          small_gemm<8>(lds, B0 + (size_t)NP * D, (const bf16*)(ws + WS_WIN), NIN, D, E, wave, lane); }
        grid.sync();
        mix_phase(P, l, lds, wave, lane);
        s5_chunk_sums(P, wave, lane);
        sample_mix(P, l, lds, wave, lane);
        grid.sync();
        s5_scan(P, l);
        grid.sync();
        s5_output(P, l, lds, wave, lane);
        grid.sync();
        { EpiGlu E{B1, B4, B0, P.in[I_BGLU] + l * D}; GEMM_PHASE(EpiGlu, B0, ws + WS_WGLU, NP, D, D, E); }
        { SEpiGlu E{sm + 5 * NS * D, sm + 4 * NS * D, B0 + (size_t)NP * D, P.in[I_BGLU] + l * D, B1 + (size_t)NP * D};
          small_gemm<8>(lds, B0 + (size_t)NP * D, (const bf16*)(ws + WS_WGLU), D, D, E, wave, lane); }
        grid.sync();
        { EpiRes E{xP, xcur, modl + (size_t)128 * NMODC + 2048}; GEMM_PHASE(EpiRes, B1, ws + WS_WOUT, NP, D, D, E); }
        { SEpiRes E{xS, xcur + (size_t)NP * D, modl + 2048};
          small_gemm<8>(lds, B1 + (size_t)NP * D, (const bf16*)(ws + WS_WOUT), D, D, E, wave, lane); }
        grid.sync();
        norm_phase(P, l, xcur, xcur + (size_t)NP * D, P.in[I_G2] + l * D, 3072, 4096, wave, lane);
        grid.sync();
        { EpiFF1 E{B1}; GEMM_PHASE(EpiFF1, B0, ws + WS_WFF1, NP, FF, D, E); }
        { SEpiFF1 E{B1 + (size_t)NP * FF}; small_gemm<8>(lds, B0 + (size_t)NP * D, (const bf16*)(ws + WS_WFF1), FF, D, E, wave, lane); }
        grid.sync();
        { EpiRes E{xcur, xcur, modl + (size_t)128 * NMODC + 5120}; GEMM_PHASE(EpiRes, B1, ws + WS_WFF2, NP, D, FF, E); }
        { SEpiRes E{xcur + (size_t)NP * D, xcur + (size_t)NP * D, modl + 5120};
          small_gemm<8>(lds, B1 + (size_t)NP * FF, (const bf16*)(ws + WS_WFF2), D, FF, E, wave, lane); }
        grid.sync();
    }
    final_norm(P, wave, lane);
}

extern "C" void kernel_launch(void* const* d_in, const int* in_sizes, int n_in, void* d_out, int out_size, void* d_ws, size_t ws_size, hipStream_t stream) {
    static int grid_blocks = 0;
    if (grid_blocks == 0) {
        if (n_in != 28 || ws_size < WS_END) { fprintf(stderr, "kernel_launch: unexpected n_in %d / ws_size %zu (need %zu)\n", n_in, ws_size, (size_t)WS_END); grid_blocks = -1; return; }
        int dev = 0, cus = 0, per_cu = 0;
        hipGetDevice(&dev); hipDeviceGetAttribute(&cus, hipDeviceAttributeMultiprocessorCount, dev);
        if (hipFuncSetAttribute((const void*)fwd_kernel, hipFuncAttributeMaxDynamicSharedMemorySize, LDS_BYTES) != hipSuccess) { fprintf(stderr, "kernel_launch: hipFuncSetAttribute failed\n"); grid_blocks = -1; return; }
        if (hipOccupancyMaxActiveBlocksPerMultiprocessor(&per_cu, (const void*)fwd_kernel, 512, LDS_BYTES) != hipSuccess || per_cu < 1) { fprintf(stderr, "kernel_launch: occupancy query says %d blocks per CU\n", per_cu); grid_blocks = -1; return; }
        grid_blocks = cus;
    }
    if (grid_blocks < 0) return;
    Params p{};
    for (int i = 0; i < 28; ++i) p.in[i] = (const float*)d_in[i];
    p.out = (float*)d_out; p.ws = (unsigned char*)d_ws;
    void* args[] = {&p};
    hipError_t e = hipLaunchCooperativeKernel((void*)fwd_kernel, dim3(grid_blocks), dim3(512), args, LDS_BYTES, stream);
    if (e != hipSuccess) fprintf(stderr, "cooperative launch failed: %s (grid %d)\n", hipGetErrorString(e), grid_blocks);
}
```

```cpp
#include <hip/hip_runtime.h>
#include <hip/hip_cooperative_groups.h>
#include <cstdio>
#include <cstdint>
namespace cg = cooperative_groups;
namespace pg8 {
#define PG8_LAS __attribute__((address_space(3)))
typedef unsigned short bf16_t;
typedef short bf16x8 __attribute__((ext_vector_type(8)));
typedef float f32x4 __attribute__((ext_vector_type(4)));
typedef unsigned u32x4 __attribute__((ext_vector_type(4)));
constexpr int BM = 256, BK = 64, HALF = 128, HTB = HALF * BK * 2  , STAGE_BYTES = 8 * HTB, NXCD = 8, WGM = 8;

__host__ __device__ __forceinline__ int lds_byte(int r, int c) { const int st = (r >> 4) * 2 + (c >> 5), rr = r & 15, cc = c & 31, ob = rr * 64 + cc * 2; return st * 1024 + (ob ^ (((ob >> 9) & 1) << 5)); }
__host__ __device__ __forceinline__ void stage_rc(int b, int& R, int& C) { const int st = b / 1024, sb = b % 1024, swz = sb ^ (((sb >> 9) & 1) << 5); R = (st >> 1) * 16 + swz / 64; C = (st & 1) * 32 + (swz % 64) / 2; }
__host__ __device__ __forceinline__ int perm32(int rho) { const int n = rho >> 4, i = rho & 15; return 8 * (i >> 2) + 4 * n + (i & 3); }

struct Unit { int pm, pn; };
struct Gemm { const bf16_t* A; const bf16_t* Bt; int M, N, K; };

struct StaticOrder {
    int nM, nN, nwg, G, c;
    __host__ __device__ void init(int M, int N, int G_, int c_) { nM = M / BM; nN = N / BM; nwg = nM * nN; G = G_; c = c_; }
    __host__ __device__ bool next(int i, Unit& u) const {
        const long L = (long)i * G + c; if (L >= nwg) return false;
        int wgid = (int)L; { const int q = nwg / NXCD, r = nwg % NXCD, xcd = wgid % NXCD, off = wgid / NXCD; wgid = (xcd < r ? xcd * (q + 1) : r * (q + 1) + (xcd - r) * q) + off; }
        const int nig = WGM * nN, gid = wgid / nig, fm = gid * WGM, gsz = (nM - fm) < WGM ? (nM - fm) : WGM;
        u.pm = fm + ((wgid % nig) % gsz); u.pn = (wgid % nig) / gsz; return true;
    }
    __device__ __forceinline__ void a_ready(const Unit&) const {}
    __device__ __forceinline__ void done(const Unit&) const {}
};

__device__ __forceinline__ unsigned cvt_pk_bf16(float lo, float hi) { unsigned r; asm volatile("v_cvt_pk_bf16_f32 %0, %1, %2" : "=v"(r) : "v"(lo), "v"(hi)); return r; }
typedef float f32x2 __attribute__((ext_vector_type(2)));
template <class Epi, class Sched, bool ALIGN_EPI = false, bool SP2 = false>
__device__ __forceinline__ void gemm_phase(PG8_LAS unsigned char* lds, const Gemm g, const Sched& S, const Epi& E) {
    int tid = threadIdx.x; asm volatile("" : "+v"(tid)); const int wid = __builtin_amdgcn_readfirstlane(tid >> 6), lane = tid & 63, wr = wid >> 2, wc = wid & 3, fr = lane & 15, fq = lane >> 4;
    const int K = g.K, nt = K / BK;
    unsigned voffA[2], voffB[2];
#pragma unroll
    for (int i = 0; i < 2; ++i) { int R, C; stage_rc(tid * 16 + i * 8192, R, C); const int Rb = Epi::PERM ? ((R & ~31) + perm32(R & 31)) : R;
        voffA[i] = (unsigned)(R * K + C) * 2u; voffB[i] = (unsigned)(Rb * K + C) * 2u; }
    const size_t kstep = (size_t)(BK * 2);
    const size_t hstep = (size_t)HALF * K * 2;
    const size_t tstep = 2 * hstep;
    const unsigned ldsw = (unsigned)wid * 1024u;
    const int aoff = lds_byte(wr * 64 + fr, fq * 8), boff = lds_byte(wc * 32 + fr, fq * 8);
#define PG8_SA(b, h) (((b) * 2 + (h)) * HTB)
#define PG8_SB(b, h) ((4 + (b) * 2 + (h)) * HTB)
#define PG8_STAGE(bufoff, gbase, voff) do { _Pragma("unroll") for (int _i = 0; _i < 2; ++_i) \
        __builtin_amdgcn_global_load_lds((const unsigned*)((const char*)(gbase) + (voff)[_i]), (PG8_LAS unsigned*)(lds + (bufoff) + ldsw + _i * 8192), 16, 0, 0); } while (0)
#define PG8_LDA(dst, b, h) do { _Pragma("unroll") for (int m = 0; m < 4; ++m) _Pragma("unroll") for (int k = 0; k < 2; ++k) dst[m][k] = *(const PG8_LAS bf16x8*)(lds + PG8_SA(b, h) + aoff + m * 2048 + k * 1024); } while (0)
#define PG8_LDB(dst, b, h) do { _Pragma("unroll") for (int n = 0; n < 2; ++n) _Pragma("unroll") for (int k = 0; k < 2; ++k) dst[n][k] = *(const PG8_LAS bf16x8*)(lds + PG8_SB(b, h) + boff + n * 2048 + k * 1024); } while (0)
#define PG8_MMA(ai, bj, At, Bt) do { __builtin_amdgcn_s_setprio(1); _Pragma("unroll") for (int m = 0; m < 4; ++m) _Pragma("unroll") for (int n = 0; n < 2; ++n) _Pragma("unroll") for (int k = 0; k < 2; ++k) \
        acc[ai][bj][m][n] = __builtin_amdgcn_mfma_f32_16x16x32_bf16(Bt[n][k], At[m][k], acc[ai][bj][m][n], 0, 0, 0); __builtin_amdgcn_s_setprio(0); } while (0)
#define PG8_WAIT_V(n) asm volatile("s_waitcnt vmcnt(" #n ")" ::: "memory")
#define PG8_WAIT_L(n) asm volatile("s_waitcnt lgkmcnt(" #n ")" ::: "memory")
#define PG8_BAR __builtin_amdgcn_s_barrier()
#define PG8_SCHED __builtin_amdgcn_sched_barrier(0)
    Unit cur, nxt; int ui = 0;
    if (!S.next(0, cur)) return;
    f32x4 acc[2][2][4][2];
#pragma unroll
    for (int a = 0; a < 2; ++a)
#pragma unroll
        for (int b = 0; b < 2; ++b)
#pragma unroll
            for (int m = 0; m < 4; ++m)
#pragma unroll
                for (int n = 0; n < 2; ++n) acc[a][b][m][n] = (f32x4){0.f, 0.f, 0.f, 0.f};
    bf16x8 At[4][2], B0[2][2], B1[2][2];
    const char* cA = (const char*)g.A + (size_t)cur.pm * tstep; const char* cB = (const char*)g.Bt + (size_t)cur.pn * tstep;
    S.a_ready(cur);
    if constexpr (SP2) {
        PG8_STAGE(PG8_SB(0, 0), cB, voffB); PG8_STAGE(PG8_SB(0, 1), cB + hstep, voffB); PG8_STAGE(PG8_SA(0, 0), cA, voffA); PG8_STAGE(PG8_SA(0, 1), cA + hstep, voffA);
        if (wr == 1) PG8_BAR;
        PG8_WAIT_V(2); PG8_BAR;
        PG8_STAGE(PG8_SB(1, 0), cB + kstep, voffB); PG8_STAGE(PG8_SA(1, 0), cA + kstep, voffA); PG8_STAGE(PG8_SB(1, 1), cB + hstep + kstep, voffB);
        PG8_WAIT_V(6); PG8_BAR;
    } else {
        PG8_STAGE(PG8_SB(0, 0), cB, voffB); PG8_STAGE(PG8_SA(0, 0), cA, voffA); PG8_STAGE(PG8_SB(0, 1), cB + hstep, voffB); PG8_STAGE(PG8_SA(0, 1), cA + hstep, voffA);
        if (wr == 1) PG8_BAR;
        PG8_WAIT_V(4); PG8_BAR;
        PG8_STAGE(PG8_SB(1, 0), cB + kstep, voffB); PG8_STAGE(PG8_SA(1, 0), cA + kstep, voffA); PG8_STAGE(PG8_SB(1, 1), cB + hstep + kstep, voffB);
        PG8_WAIT_V(6); PG8_BAR;
    }
    for (;;) {
        const bool has_next = S.next(ui + 1, nxt);
        const char* nA = has_next ? (const char*)g.A + (size_t)nxt.pm * tstep : cA; const char* nB = has_next ? (const char*)g.Bt + (size_t)nxt.pn * tstep : cB;
        for (int t = 0; t < nt; t += 2) {
            const bool last = (t == nt - 2);
            const char* a1 = cA + (size_t)(t + 1) * kstep;
            const char* a2 = last ? nA : cA + (size_t)(t + 2) * kstep; const char* b2 = last ? nB : cB + (size_t)(t + 2) * kstep;
            const char* a3 = a2 + kstep; const char* b3 = b2 + kstep;
            if (last && has_next) S.a_ready(nxt);
            if constexpr (SP2) {
            PG8_LDB(B0, 0, 0); PG8_LDB(B1, 0, 1); PG8_SCHED; PG8_LDA(At, 0, 0); PG8_STAGE(PG8_SA(1, 1), a1 + hstep, voffA);
            PG8_WAIT_V(8); PG8_WAIT_L(0); PG8_BAR; PG8_MMA(0, 0, At, B0); PG8_MMA(0, 1, At, B1); PG8_BAR; PG8_SCHED;
            PG8_LDA(At, 0, 1); PG8_STAGE(PG8_SB(0, 0), b2, voffB); PG8_STAGE(PG8_SB(0, 1), b2 + hstep, voffB); PG8_STAGE(PG8_SA(0, 0), a2, voffA);
            PG8_WAIT_V(8); PG8_WAIT_L(0); PG8_BAR; PG8_MMA(1, 0, At, B0); PG8_MMA(1, 1, At, B1); PG8_BAR; PG8_SCHED;
            PG8_LDB(B0, 1, 0); PG8_LDB(B1, 1, 1); PG8_SCHED; PG8_LDA(At, 1, 0); PG8_STAGE(PG8_SA(0, 1), a2 + hstep, voffA);
            PG8_WAIT_V(8); PG8_WAIT_L(0); PG8_BAR; PG8_MMA(0, 0, At, B0); PG8_MMA(0, 1, At, B1); PG8_BAR; PG8_SCHED;
            PG8_LDA(At, 1, 1); PG8_STAGE(PG8_SB(1, 0), b3, voffB); PG8_STAGE(PG8_SB(1, 1), b3 + hstep, voffB); PG8_STAGE(PG8_SA(1, 0), a3, voffA);
            PG8_WAIT_V(8); PG8_WAIT_L(0); PG8_BAR; PG8_MMA(1, 0, At, B0); PG8_MMA(1, 1, At, B1); PG8_BAR; PG8_SCHED;
            } else {
            PG8_LDB(B0, 0, 0); PG8_SCHED; PG8_LDA(At, 0, 0); PG8_STAGE(PG8_SA(1, 1), a1 + hstep, voffA);
            PG8_WAIT_L(8); PG8_BAR; PG8_WAIT_L(0); PG8_MMA(0, 0, At, B0); PG8_BAR; PG8_SCHED;
            PG8_LDB(B1, 0, 1); PG8_STAGE(PG8_SB(0, 0), b2, voffB);
            PG8_BAR; PG8_WAIT_L(0); PG8_MMA(0, 1, At, B1); PG8_BAR;
            PG8_LDA(At, 0, 1); PG8_STAGE(PG8_SA(0, 0), a2, voffA);
            PG8_BAR; PG8_WAIT_L(0); PG8_MMA(1, 0, At, B0); PG8_BAR; PG8_SCHED;
            PG8_STAGE(PG8_SB(0, 1), b2 + hstep, voffB);
            PG8_WAIT_V(6); PG8_BAR; PG8_MMA(1, 1, At, B1); PG8_BAR;
            PG8_LDB(B0, 1, 0); PG8_SCHED; PG8_LDA(At, 1, 0); PG8_STAGE(PG8_SA(0, 1), a2 + hstep, voffA);
            PG8_WAIT_L(8); PG8_BAR; PG8_WAIT_L(0); PG8_MMA(0, 0, At, B0); PG8_BAR; PG8_SCHED;
            PG8_LDB(B1, 1, 1); PG8_STAGE(PG8_SB(1, 0), b3, voffB);
            PG8_BAR; PG8_WAIT_L(0); PG8_MMA(0, 1, At, B1); PG8_BAR;
            PG8_LDA(At, 1, 1); PG8_STAGE(PG8_SA(1, 0), a3, voffA);
            PG8_BAR; PG8_WAIT_L(0); PG8_MMA(1, 0, At, B0); PG8_BAR; PG8_SCHED;
            PG8_STAGE(PG8_SB(1, 1), b3 + hstep, voffB);
            PG8_WAIT_V(6); PG8_BAR; PG8_MMA(1, 1, At, B1); PG8_BAR;
            }
        }
        if constexpr (ALIGN_EPI) { if (wr == 0) PG8_BAR; }
        if constexpr (!Epi::AFTER_DRAIN) { E(acc, cur, wr, wc, fr, fq); S.done(cur); }
        if (!has_next) break;
#pragma unroll
        for (int a = 0; a < 2; ++a)
#pragma unroll
            for (int b = 0; b < 2; ++b)
#pragma unroll
                for (int m = 0; m < 4; ++m)
#pragma unroll
                    for (int n = 0; n < 2; ++n) acc[a][b][m][n] = (f32x4){0.f, 0.f, 0.f, 0.f};
        cur = nxt; cA = nA; cB = nB; ++ui;
        if constexpr (ALIGN_EPI) { if (wr == 1) PG8_BAR; }
    }
    PG8_WAIT_V(0);
    if constexpr (!ALIGN_EPI) { if (wr == 0) PG8_BAR; }
    PG8_BAR;
    if constexpr (Epi::AFTER_DRAIN) { E.fused(acc, cur, wr, wc, fr, fq, lds, wid, lane); S.done(cur); }
#undef PG8_SA
#undef PG8_SB
#undef PG8_STAGE
#undef PG8_LDA
#undef PG8_LDB
#undef PG8_MMA
#undef PG8_WAIT_V
#undef PG8_WAIT_L
#undef PG8_BAR
#undef PG8_SCHED
}
}

typedef unsigned short bf16;
typedef short bf16x8 __attribute__((ext_vector_type(8)));
typedef float f32x4 __attribute__((ext_vector_type(4)));
typedef unsigned u32x4 __attribute__((ext_vector_type(4)));
typedef unsigned u32x2 __attribute__((ext_vector_type(2)));
#define LAS __attribute__((address_space(3)))

constexpr int D = 1024, NP = 16384, NS = 128, NR = NP + NS, NIN = 5120, FF = 4096;
constexpr int NMODR = 136, NMODC = 6144;
constexpr float EPS = 1e-6f;
constexpr int LDS_BYTES = 148 * 1024;

enum { I_XP = 0, I_XS, I_CP, I_CS, I_SRE, I_SIM, I_WADA, I_BADA, I_G1, I_G2, I_WIN, I_GV, I_WSP, I_BSP, I_LRE, I_LIM, I_LDT,
       I_BRE, I_BIM, I_CRE, I_CIM, I_DSK, I_WGLU, I_BGLU, I_WOUT, I_WFF1, I_WFF2, I_GFIN };
constexpr size_t O_YP = 0, O_YS = 16777216, O_RP = O_YS + 131072, O_IP = O_RP + 65536, O_RS = O_IP + 65536, O_IS = O_RS + 1048576, O_V = O_IS + 1048576;
constexpr size_t MiB = 1u << 20;
constexpr size_t ACTB = (size_t)NR * D * 2;
constexpr size_t WS_SSQ = 0, WS_CSILU = 1 * MiB, WS_WSB = 2 * MiB, WS_SMALL = 3 * MiB, WS_MOD = 6 * MiB, WS_S5F = 13 * MiB, WS_KTAB = 14 * MiB,
                 WS_WS = 16 * MiB, WS_WY = 24 * MiB, WS_WIN = 32 * MiB, WS_WGLU = 42 * MiB, WS_WOUT = 44 * MiB, WS_WFF1 = 46 * MiB, WS_WFF2 = 54 * MiB,
                 WS_SC = 62 * MiB, WS_HIN = 78 * MiB, WS_B0 = 86 * MiB, WS_B1 = WS_B0 + ACTB, WS_B2 = WS_B1 + ACTB, WS_B3 = WS_B2 + ACTB, WS_B4 = WS_B3 + ACTB,
                 WS_END = WS_B4 + ACTB;
constexpr size_t WS_BAR = 128 * 1024;
constexpr size_t SMALLB = (size_t)NS * D * 4;

struct Params { const float* in[28]; float* out; unsigned char* ws; };

__device__ __forceinline__ float bf2f(unsigned b) { return __uint_as_float(b << 16); }
__device__ __forceinline__ unsigned f2bf(float f) { unsigned u = __float_as_uint(f); return (u + 0x7fffu + ((u >> 16) & 1u)) >> 16; }
__device__ __forceinline__ unsigned pk2(float lo, float hi) { return pg8::cvt_pk_bf16(lo, hi); }
__device__ __forceinline__ float blo(unsigned w) { return __uint_as_float(w << 16); }
__device__ __forceinline__ float bhi(unsigned w) { return __uint_as_float(w & 0xffff0000u); }
__device__ __forceinline__ float sigmoid_f(float x) { return __builtin_amdgcn_rcpf(1.0f + __builtin_amdgcn_exp2f(-1.4426950409f * x)); }
__device__ __forceinline__ float gelu_t(float x) { const float y = x * (1.5957691216f + 0.0713548163f * x * x); return x * __builtin_amdgcn_rcpf(1.0f + __builtin_amdgcn_exp2f(-1.4426950409f * y)); }
__device__ __forceinline__ float wave_sum(float v) {
#pragma unroll
    for (int o = 1; o < 64; o <<= 1) v += __shfl_xor(v, o);
    return v;
}
__device__ __forceinline__ int otid() { int t = threadIdx.x; asm volatile("" : "+v"(t)); return t; }
#define LDS_FENCE() asm volatile("s_waitcnt lgkmcnt(0)" ::: "memory")
#define MFMA16(a, b, c) __builtin_amdgcn_mfma_f32_16x16x32_bf16((a), (b), (c), 0, 0, 0)

struct EpiIn {
    static constexpr bool PERM = true, AFTER_DRAIN = false;
    bf16 *ug, *v, *ps, *sgb; float* ssq;
    __device__ __forceinline__ void operator()(const f32x4 (&acc)[2][2][4][2], const pg8::Unit& u, int wr, int wc, int fr, int fq) const {
        const int row0 = u.pm * 256 + wr * 64 + fr;
        if (u.pn < 8) {
            const int col0 = u.pn * 128 + wc * 32 + 8 * fq;
#pragma unroll
            for (int ai = 0; ai < 2; ++ai)
#pragma unroll
                for (int m = 0; m < 4; ++m) {
                    const size_t off = (size_t)(row0 + ai * 128 + m * 16) * D + col0;
                    float o[8];
#pragma unroll
                    for (int n = 0; n < 2; ++n)
#pragma unroll
                        for (int j = 0; j < 4; ++j) o[n * 4 + j] = gelu_t(acc[ai][0][m][n][j]) * sigmoid_f(acc[ai][1][m][n][j]);
                    u32x4 w; w.x = pk2(o[0], o[1]); w.y = pk2(o[2], o[3]); w.z = pk2(o[4], o[5]); w.w = pk2(o[6], o[7]);
                    *(u32x4*)(ug + off) = w;
                }
        } else if (u.pn < 12) {
#pragma unroll
            for (int ai = 0; ai < 2; ++ai)
#pragma unroll
                for (int m = 0; m < 4; ++m) {
                    const int row = row0 + ai * 128 + m * 16; float ss = 0.f;
#pragma unroll
                    for (int bj = 0; bj < 2; ++bj) {
                        const int col0 = (u.pn - 8) * 256 + bj * 128 + wc * 32 + 8 * fq;
                        float o[8];
#pragma unroll
                        for (int n = 0; n < 2; ++n)
#pragma unroll
                            for (int j = 0; j < 4; ++j) { const float g = gelu_t(acc[ai][bj][m][n][j]); o[n * 4 + j] = g; ss += g * g; }
                        u32x4 w; w.x = pk2(o[0], o[1]); w.y = pk2(o[2], o[3]); w.z = pk2(o[4], o[5]); w.w = pk2(o[6], o[7]);
                        *(u32x4*)(v + (size_t)row * D + col0) = w;
                    }
                    ss += __shfl_xor(ss, 16); ss += __shfl_xor(ss, 32);
                    if (fq == 0) atomicAdd(ssq + row, ss);
                }
        } else {
            const bool isS = u.pn < 16; bf16* dst = isS ? ps : sgb; const int cb = (u.pn - (isS ? 12 : 16)) * 256;
#pragma unroll
            for (int ai = 0; ai < 2; ++ai)
#pragma unroll
                for (int m = 0; m < 4; ++m)
#pragma unroll
                    for (int bj = 0; bj < 2; ++bj) {
                        const size_t off = (size_t)(row0 + ai * 128 + m * 16) * D + cb + bj * 128 + wc * 32 + 8 * fq;
                        float o[8];
#pragma unroll
                        for (int n = 0; n < 2; ++n)
#pragma unroll
                            for (int j = 0; j < 4; ++j) { const float a = acc[ai][bj][m][n][j]; o[n * 4 + j] = isS ? a : sigmoid_f(a); }
                        u32x4 w; w.x = pk2(o[0], o[1]); w.y = pk2(o[2], o[3]); w.z = pk2(o[4], o[5]); w.w = pk2(o[6], o[7]);
                        *(u32x4*)(dst + off) = w;
                    }
        }
    }
};
struct EpiGlu {
    static constexpr bool PERM = true, AFTER_DRAIN = false;
    bf16* apart; const bf16* sgb; const bf16* z; const float* bglu;
    __device__ __forceinline__ void operator()(const f32x4 (&acc)[2][2][4][2], const pg8::Unit& u, int wr, int wc, int fr, int fq) const {
        const int row0 = u.pm * 256 + wr * 64 + fr;
#pragma unroll
        for (int bj = 0; bj < 2; ++bj) {
            const int col0 = u.pn * 256 + bj * 128 + wc * 32 + 8 * fq;
            const f32x4 b0 = *(const f32x4*)(bglu + col0), b1 = *(const f32x4*)(bglu + col0 + 4);
#pragma unroll
            for (int ai = 0; ai < 2; ++ai)
#pragma unroll
                for (int m = 0; m < 4; ++m) {
                    const size_t off = (size_t)(row0 + ai * 128 + m * 16) * D + col0;
                    const u32x4 wa = *(const u32x4*)(apart + off), wg = *(const u32x4*)(sgb + off), wz = *(const u32x4*)(z + off);
                    float o[8];
#pragma unroll
                    for (int q = 0; q < 4; ++q) {
                        const float a0 = acc[ai][bj][m][q >> 1][(q & 1) * 2] + ((q >> 1) ? b1 : b0)[(q & 1) * 2];
                        const float a1 = acc[ai][bj][m][q >> 1][(q & 1) * 2 + 1] + ((q >> 1) ? b1 : b0)[(q & 1) * 2 + 1];
                        o[2 * q] = blo(wa[q]) + blo(wg[q]) * blo(wz[q]) * sigmoid_f(a0);
                        o[2 * q + 1] = bhi(wa[q]) + bhi(wg[q]) * bhi(wz[q]) * sigmoid_f(a1);
                    }
                    u32x4 w; w.x = pk2(o[0], o[1]); w.y = pk2(o[2], o[3]); w.z = pk2(o[4], o[5]); w.w = pk2(o[6], o[7]);
                    *(u32x4*)(apart + off) = w;
                }
        }
    }
};
struct EpiRes {
    static constexpr bool PERM = false, AFTER_DRAIN = false;
    const float* xold; float* xout; const float* gt;
    __device__ __forceinline__ void operator()(const f32x4 (&acc)[2][2][4][2], const pg8::Unit& u, int wr, int wc, int fr, int fq) const {
        const int row0 = u.pm * 256 + wr * 64 + fr, col0 = u.pn * 256 + wc * 32 + 4 * fq;
        const float* g = gt + (size_t)(u.pm >> 3) * NMODC;
        f32x4 gv[2][2];
#pragma unroll
        for (int bj = 0; bj < 2; ++bj)
#pragma unroll
            for (int n = 0; n < 2; ++n) gv[bj][n] = *(const f32x4*)(g + col0 + bj * 128 + n * 16);
#pragma unroll
        for (int ai = 0; ai < 2; ++ai)
#pragma unroll
            for (int m = 0; m < 4; ++m) {
                const size_t off = (size_t)(row0 + ai * 128 + m * 16) * D + col0;
#pragma unroll
                for (int bj = 0; bj < 2; ++bj)
#pragma unroll
                    for (int n = 0; n < 2; ++n) {
                        const f32x4 xo = *(const f32x4*)(xold + off + bj * 128 + n * 16);
                        *(f32x4*)(xout + off + bj * 128 + n * 16) = xo + gv[bj][n] * acc[ai][bj][m][n];
                    }
            }
    }
};
struct EpiFF1 {
    static constexpr bool PERM = true, AFTER_DRAIN = false;
    bf16* act;
    __device__ __forceinline__ void operator()(const f32x4 (&acc)[2][2][4][2], const pg8::Unit& u, int wr, int wc, int fr, int fq) const {
        const int row0 = u.pm * 256 + wr * 64 + fr;
#pragma unroll
        for (int ai = 0; ai < 2; ++ai)
#pragma unroll
            for (int m = 0; m < 4; ++m)
#pragma unroll
                for (int bj = 0; bj < 2; ++bj) {
                    const size_t off = (size_t)(row0 + ai * 128 + m * 16) * FF + u.pn * 256 + bj * 128 + wc * 32 + 8 * fq;
                    float o[8];
#pragma unroll
                    for (int n = 0; n < 2; ++n)
#pragma unroll
                        for (int j = 0; j < 4; ++j) { const float a = fmaxf(acc[ai][bj][m][n][j], 0.f); o[n * 4 + j] = a * a; }
                    u32x4 w; w.x = pk2(o[0], o[1]); w.y = pk2(o[2], o[3]); w.z = pk2(o[4], o[5]); w.w = pk2(o[6], o[7]);
                    *(u32x4*)(act + off) = w;
                }
    }
};

template <int MB, class Epi>
__device__ __forceinline__ void small_gemm(unsigned char* lds, const bf16* A, const bf16* Bt, int N, int K, const Epi& E, int wave, int lane) {
    const int tid = otid(); lane = tid & 63; wave = __builtin_amdgcn_readfirstlane(tid >> 6);
    const int fr = lane & 15, fq = lane >> 4;
    f32x4* red = (f32x4*)lds;
    const int kw = K >> 3;
    for (int nb = blockIdx.x; nb < (N >> 4); nb += gridDim.x) {
        f32x4 acc[MB];
#pragma unroll
        for (int mb = 0; mb < MB; ++mb) acc[mb] = (f32x4){0.f, 0.f, 0.f, 0.f};
        const bf16* bp = Bt + (size_t)(nb * 16 + fr) * K + wave * kw + fq * 8;
        const bf16* ap = A + (size_t)fr * K + wave * kw + fq * 8;
#pragma unroll 2
        for (int ks = 0; ks < kw; ks += 32) {
            const bf16x8 b = *(const bf16x8*)(bp + ks);
#pragma unroll
            for (int mb = 0; mb < MB; ++mb) { const bf16x8 a = *(const bf16x8*)(ap + (size_t)mb * 16 * K + ks); acc[mb] = MFMA16(b, a, acc[mb]); }
        }
#pragma unroll
        for (int mb = 0; mb < MB; ++mb) red[(wave * MB + mb) * 64 + lane] = acc[mb];
        __syncthreads();
        for (int e = tid; e < MB * 64; e += 512) {
            const int mb = e >> 6, ln = e & 63; f32x4 s = red[mb * 64 + ln];
#pragma unroll
            for (int w = 1; w < 8; ++w) s += red[(w * MB + mb) * 64 + ln];
            E(mb * 16 + (ln & 15), nb * 16 + (ln >> 4) * 4, s);
        }
        __syncthreads();
    }
}
struct SEpiAda { float* mod; const float* bias;
    __device__ __forceinline__ void operator()(int row, int col, f32x4 v) const { if (row < NMODR) *(f32x4*)(mod + (size_t)row * NMODC + col) = v + *(const f32x4*)(bias + col); } };
struct SEpiIn { float *gu, *sga, *gv, *ps, *sgb;
    __device__ __forceinline__ void operator()(int row, int col, f32x4 v) const {
        if (col < 2048) { const int tile = col >> 8, w = col & 255;
            if (w < 128) { f32x4 o; for (int j = 0; j < 4; ++j) o[j] = gelu_t(v[j]); *(f32x4*)(gu + (size_t)row * D + tile * 128 + w) = o; }
            else { f32x4 o; for (int j = 0; j < 4; ++j) o[j] = sigmoid_f(v[j]); *(f32x4*)(sga + (size_t)row * D + tile * 128 + w - 128) = o; } }
        else if (col < 3072) { f32x4 o; for (int j = 0; j < 4; ++j) o[j] = gelu_t(v[j]); *(f32x4*)(gv + (size_t)row * D + col - 2048) = o; }
        else if (col < 4096) { *(f32x4*)(ps + (size_t)row * D + col - 3072) = v; }
        else { f32x4 o; for (int j = 0; j < 4; ++j) o[j] = sigmoid_f(v[j]); *(f32x4*)(sgb + (size_t)row * D + col - 4096) = o; }
    } };
struct SEpiGlu { const float* apart; const float* sgb; const bf16* z; const float* bglu; bf16* merged;
    __device__ __forceinline__ void operator()(int row, int col, f32x4 v) const {
        const size_t off = (size_t)row * D + col; const u32x2 wz = *(const u32x2*)(z + off); const f32x4 a = *(const f32x4*)(apart + off), g = *(const f32x4*)(sgb + off), b = *(const f32x4*)(bglu + col);
        const float o0 = a[0] + g[0] * blo(wz.x) * sigmoid_f(v[0] + b[0]), o1 = a[1] + g[1] * bhi(wz.x) * sigmoid_f(v[1] + b[1]);
        const float o2 = a[2] + g[2] * blo(wz.y) * sigmoid_f(v[2] + b[2]), o3 = a[3] + g[3] * bhi(wz.y) * sigmoid_f(v[3] + b[3]);
        u32x2 w; w.x = pk2(o0, o1); w.y = pk2(o2, o3); *(u32x2*)(merged + off) = w;
    } };
struct SEpiRes { const float* xold; float* xout; const float* gt;
    __device__ __forceinline__ void operator()(int row, int col, f32x4 v) const {
        const size_t off = (size_t)row * D + col; *(f32x4*)(xout + off) = *(const f32x4*)(xold + off) + *(const f32x4*)(gt + (size_t)row * NMODC + col) * v; } };
struct SEpiFF1 { bf16* act;
    __device__ __forceinline__ void operator()(int row, int col, f32x4 v) const {
        float o[4]; for (int j = 0; j < 4; ++j) { const float a = fmaxf(v[j], 0.f); o[j] = a * a; }
        u32x2 w; w.x = pk2(o[0], o[1]); w.y = pk2(o[2], o[3]); *(u32x2*)(act + (size_t)row * FF + col) = w; } };

__device__ __forceinline__ void transpose_item(const float* W, int K, int N, bf16* WT, int k0, int n0, int drow0, float* scr, int lane) {
#pragma unroll 8
    for (int i = 0; i < 32; ++i) { const int kk = 2 * i + (lane >> 5); scr[kk * 33 + (lane & 31)] = W[(size_t)(k0 + kk) * N + n0 + (lane & 31)]; }
    LDS_FENCE();
    const int c = lane & 7;
#pragma unroll
    for (int j = 0; j < 4; ++j) { const int n = (lane >> 3) + 8 * j; const float* s = scr + (8 * c) * 33 + n;
        u32x4 o; o.x = pk2(s[0 * 33], s[1 * 33]); o.y = pk2(s[2 * 33], s[3 * 33]); o.z = pk2(s[4 * 33], s[5 * 33]); o.w = pk2(s[6 * 33], s[7 * 33]);
        *(u32x4*)(WT + (size_t)(drow0 + n) * K + k0 + 8 * c) = o; }
    LDS_FENCE();
}
__device__ __forceinline__ int perm_in(int n) {
    if (n < 1024) return ((n >> 7) << 8) + (n & 127);
    if (n < 3072) return n + 1024;
    if (n < 4096) { const int m = n - 3072; return ((m >> 7) << 8) + 128 + (m & 127); }
    return n;
}
__device__ __forceinline__ float2 cmul(float2 a, float2 b) { return make_float2(a.x * b.x - a.y * b.y, a.x * b.y + a.y * b.x); }

__device__ __forceinline__ void prep_layer(const Params& P, int l, unsigned char* lds, int wave, int lane) {
    const int tid = otid(); lane = tid & 63; wave = __builtin_amdgcn_readfirstlane(tid >> 6);
    unsigned char* ws = P.ws;
    float2* apow = (float2*)lds;
    float2* Bb = (float2*)(lds + 16896);
    float2* Cc = (float2*)(lds + 16896 + 8192);
    bf16* ktab = (bf16*)(ws + WS_KTAB); bf16* WS_ = (bf16*)(ws + WS_WS); bf16* WY_ = (bf16*)(ws + WS_WY);
    float2* abar_f = (float2*)(ws + WS_S5F); float2* aT_f = abar_f + 4096; float2* bbar_f = abar_f + 8192;
    for (int wt = blockIdx.x; wt < 256; wt += gridDim.x) {
        const int g = wt >> 2, q = wt & 3, lg = l * 64 + g;
        const float dt = __expf(P.in[I_LDT][lg]);
        for (int e = tid; e < 33 * 64; e += 512) {
            const int tau = e >> 6, p = e & 63; const float lr = P.in[I_LRE][lg * 64 + p], li = P.in[I_LIM][lg * 64 + p];
            const float mag = __expf(lr * dt * (float)tau); float tr = li * dt * (float)tau * 0.15915494309f; tr -= rintf(tr);
            apow[e] = make_float2(mag * __builtin_amdgcn_cosf(tr), mag * __builtin_amdgcn_sinf(tr));
        }
        for (int e = tid; e < 1024; e += 512) {
            const int p = e >> 4, hh = e & 15; const float lr = P.in[I_LRE][lg * 64 + p], li = P.in[I_LIM][lg * 64 + p];
            const float x = lr * dt; const float em1 = (fabsf(x) < 0.1f) ? x * (1.f + x * (0.5f + x * (0.16666667f + x * (0.041666667f + x * 0.0083333333f)))) : (__expf(x) - 1.f);
            float tr = li * dt * 0.15915494309f; tr -= rintf(tr);
            const float cs = __builtin_amdgcn_cosf(tr), sn = __builtin_amdgcn_sinf(tr), sh = __builtin_amdgcn_sinf(tr * 0.5f);
            const float ar1 = em1 * cs - 2.f * sh * sh, ai = (em1 + 1.f) * sn;
            const float inv = 1.f / (lr * lr + li * li);
            const float2 coef = make_float2((ar1 * lr + ai * li) * inv, (ai * lr - ar1 * li) * inv);
            const size_t bi = ((size_t)lg * 64 + p) * 16 + hh;
            Bb[e] = cmul(coef, make_float2(P.in[I_BRE][bi], P.in[I_BIM][bi]));
            const int h2 = e >> 6, p2 = e & 63; const size_t ci = ((size_t)lg * 16 + h2) * 64 + p2;
            Cc[e] = make_float2(P.in[I_CRE][ci], P.in[I_CIM][ci]);
        }
        __syncthreads();
        if (q == 0) {
            for (int e = tid; e < 64; e += 512) { abar_f[g * 64 + e] = apow[64 + e]; aT_f[g * 64 + e] = apow[32 * 64 + e]; }
            for (int e = tid; e < 1024; e += 512) bbar_f[g * 1024 + e] = Bb[e];
            for (int e = tid; e < 256; e += 512) ktab[(size_t)(g * 33) * 256 + e] = 0;
        }
        for (int e = tid; e < 8 * 256; e += 512) {
            const int ti = q * 8 + 1 + (e >> 8), tau = ti - 1, h = (e >> 4) & 15, hh = e & 15; float s = 0.f;
            for (int p = 0; p < 64; ++p) { const float2 ca = cmul(Cc[h * 64 + p], apow[tau * 64 + p]); const float2 b = Bb[p * 16 + hh]; s += ca.x * b.x - ca.y * b.y; }
            ktab[(size_t)(g * 33 + ti) * 256 + (e & 255)] = (bf16)f2bf(s);
        }
        for (int e = tid; e < 32 * 512; e += 512) {
            const int n = 32 * q + (e >> 9), k = e & 511, p = n >> 1, s = k >> 4, hh = k & 15;
            const float2 v = cmul(apow[(31 - s) * 64 + p], Bb[p * 16 + hh]);
            WS_[((size_t)g * 128 + n) * 512 + k] = (bf16)f2bf((n & 1) ? v.y : v.x);
        }
        for (int e = tid; e < 128 * 128; e += 512) {
            const int row = 128 * q + (e >> 7), k = e & 127, t = row >> 4, h = row & 15, p = k >> 1;
            const float2 ca = cmul(Cc[h * 64 + p], apow[(t + 1) * 64 + p]);
            WY_[((size_t)g * 512 + row) * 128 + k] = (bf16)f2bf((k & 1) ? -ca.y : ca.x);
        }
        __syncthreads();
    }
    float* scr = (float*)(lds + wave * 8448);
    const int gw = blockIdx.x * 8 + wave, NGW = gridDim.x * 8;
    const float* w_in = P.in[I_WIN] + (size_t)l * D * NIN; const float* w_glu = P.in[I_WGLU] + (size_t)l * D * D; const float* w_out = P.in[I_WOUT] + (size_t)l * D * D;
    const float* w_ff1 = P.in[I_WFF1] + (size_t)l * D * FF; const float* w_ff2 = P.in[I_WFF2] + (size_t)l * FF * D;
    constexpr int IT_IN = 16 * 160, IT_G = 16 * 32, IT_F1 = 16 * 128, IT_F2 = 64 * 32, IT_ALL = IT_IN + 2 * IT_G + IT_F1 + IT_F2;
    for (int it = gw; it < IT_ALL; it += NGW) {
        int r = it;
        if (r < IT_IN) { const int kb = r / 160, nb = r % 160; transpose_item(w_in, D, NIN, (bf16*)(ws + WS_WIN), kb * 64, nb * 32, perm_in(nb * 32), scr, lane); continue; } r -= IT_IN;
        if (r < IT_G) { const int kb = r / 32, nb = r % 32; transpose_item(w_glu, D, D, (bf16*)(ws + WS_WGLU), kb * 64, nb * 32, nb * 32, scr, lane); continue; } r -= IT_G;
        if (r < IT_G) { const int kb = r / 32, nb = r % 32; transpose_item(w_out, D, D, (bf16*)(ws + WS_WOUT), kb * 64, nb * 32, nb * 32, scr, lane); continue; } r -= IT_G;
        if (r < IT_F1) { const int kb = r / 128, nb = r % 128; transpose_item(w_ff1, D, FF, (bf16*)(ws + WS_WFF1), kb * 64, nb * 32, nb * 32, scr, lane); continue; } r -= IT_F1;
        { const int kb = r / 32, nb = r % 32; transpose_item(w_ff2, FF, D, (bf16*)(ws + WS_WFF2), kb * 64, nb * 32, nb * 32, scr, lane); }
    }
}
__device__ __forceinline__ void prep_misc(const Params& P, unsigned char* lds, int wave, int lane) {
    unsigned char* ws = P.ws;
    const int tid = otid(); lane = tid & 63; wave = __builtin_amdgcn_readfirstlane(tid >> 6);
    float* scr = (float*)(lds + wave * 8448);
    const int gw = blockIdx.x * 8 + wave, NGW = gridDim.x * 8;
    constexpr int IT_A = 16 * 192;
    for (int it = gw; it < 2 * IT_A; it += NGW) {
        const int l = it / IT_A, r = it % IT_A, kb = r / 192, nb = r % 192;
        transpose_item(P.in[I_WADA] + (size_t)l * D * NMODC, D, NMODC, (bf16*)(ws + WS_B1) + (size_t)l * NMODC * D, kb * 64, nb * 32, nb * 32, scr, lane);
    }
    const int gt = blockIdx.x * 512 + tid, NGT = gridDim.x * 512;
    bf16* cs = (bf16*)(ws + WS_CSILU);
    for (int e = gt; e < 144 * D; e += NGT) {
        const int r = e >> 10, c = e & 1023; float x = 0.f;
        if (r < 128) x = P.in[I_CS][r * D + c]; else if (r < 136) x = P.in[I_CP][(r - 128) * D + c];
        cs[e] = (bf16)f2bf(x * sigmoid_f(x));
    }
    bf16* wsb = (bf16*)(ws + WS_WSB);
    for (int e = gt; e < 2 * 4 * 128 * 128; e += NGT) { const int s = e & 127, t = (e >> 7) & 127; wsb[e] = (bf16)f2bf(s <= t ? P.in[I_WSP][e] : 0.f); }
}

__device__ __forceinline__ void norm_phase(const Params& P, int l, const float* xP, const float* xS, const float* gn, int shoff, int scoff, int wave, int lane) {
    { const int tid = otid(); lane = tid & 63; wave = __builtin_amdgcn_readfirstlane(tid >> 6); }
    const int gw = blockIdx.x * 8 + wave, NGW = gridDim.x * 8;
    bf16* hb = (bf16*)(P.ws + WS_B0);
    const float* mod = (const float*)(P.ws + WS_MOD) + (size_t)l * NMODR * NMODC;
    for (int r = gw; r < NR; r += NGW) {
        const float* xr = (r < NP) ? xP + (size_t)r * D : xS + (size_t)(r - NP) * D;
        const float* mr = mod + (size_t)((r < NP) ? 128 + (r >> 11) : r - NP) * NMODC;
        f32x4 v[4]; float ss = 0.f;
#pragma unroll
        for (int j = 0; j < 4; ++j) { v[j] = *(const f32x4*)(xr + (lane + 64 * j) * 4); ss += (v[j].x * v[j].x + v[j].y * v[j].y) + (v[j].z * v[j].z + v[j].w * v[j].w); }
        const float rstd = rsqrtf(wave_sum(ss) * (1.f / D) + EPS);
#pragma unroll
        for (int j = 0; j < 4; ++j) {
            const int c = (lane + 64 * j) * 4;
            const f32x4 g = *(const f32x4*)(gn + c), sc = *(const f32x4*)(mr + scoff + c), sh = *(const f32x4*)(mr + shoff + c);
            const f32x4 o = v[j] * rstd * g * (1.f + sc) + sh;
            u32x2 w; w.x = pk2(o.x, o.y); w.y = pk2(o.z, o.w); *(u32x2*)(hb + (size_t)r * D + c) = w;
        }
    }
}
__device__ __forceinline__ void final_norm(const Params& P, int wave, int lane) {
    { const int tid = otid(); lane = tid & 63; wave = __builtin_amdgcn_readfirstlane(tid >> 6); }
    const int gw = blockIdx.x * 8 + wave, NGW = gridDim.x * 8;
    for (int r = gw; r < NR; r += NGW) {
        float* xr = P.out + (size_t)r * D;
        f32x4 v[4]; float ss = 0.f;
#pragma unroll
        for (int j = 0; j < 4; ++j) { v[j] = *(const f32x4*)(xr + (lane + 64 * j) * 4); ss += (v[j].x * v[j].x + v[j].y * v[j].y) + (v[j].z * v[j].z + v[j].w * v[j].w); }
        const float rstd = rsqrtf(wave_sum(ss) * (1.f / D) + EPS);
#pragma unroll
        for (int j = 0; j < 4; ++j) { const int c = (lane + 64 * j) * 4; *(f32x4*)(xr + c) = v[j] * rstd * *(const f32x4*)(P.in[I_GFIN] + c); }
    }
}

__device__ __forceinline__ void mix_phase(const Params& P, int l, unsigned char* lds, int wave, int lane) {
    const int tid = otid(); lane = tid & 63; wave = __builtin_amdgcn_readfirstlane(tid >> 6);
    const int fr = lane & 15, fq = lane >> 4;
    unsigned char* ws = P.ws;
    bf16* ug = (bf16*)(ws + WS_B1); const bf16* vb = (const bf16*)(ws + WS_B2); const float* ssq = (const float*)(ws + WS_SSQ);
    const float* gv = P.in[I_GV] + l * D; const float* bsp = P.in[I_BSP] + l * 512; const bf16* wsb = (const bf16*)(ws + WS_WSB) + (size_t)l * 4 * 128 * 128;
    bf16* vt = (bf16*)lds;
    for (int wt = blockIdx.x; wt < 2048; wt += gridDim.x) {
        const int dsub = wt & 3, h = (wt >> 2) & 3, cc = wt >> 4, tok0 = cc * 128, cb = h * 256 + dsub * 64;
        {
            const int s = tid >> 2, dq = tid & 3;
            const float r = rsqrtf(ssq[tok0 + s] * (1.f / D) + EPS);
            const bf16* src = vb + (size_t)(tok0 + s) * D + cb + dq * 16;
            const u32x4 a = *(const u32x4*)src, b = *(const u32x4*)(src + 8);
            const float* gp = gv + cb + dq * 16;
            bf16* dst = vt + (dq * 16) * 136 + s;
#pragma unroll
            for (int j = 0; j < 4; ++j) {
                dst[(2 * j) * 136] = (bf16)f2bf(blo(a[j]) * r * gp[2 * j]); dst[(2 * j + 1) * 136] = (bf16)f2bf(bhi(a[j]) * r * gp[2 * j + 1]);
                dst[(8 + 2 * j) * 136] = (bf16)f2bf(blo(b[j]) * r * gp[8 + 2 * j]); dst[(9 + 2 * j) * 136] = (bf16)f2bf(bhi(b[j]) * r * gp[9 + 2 * j]);
            }
        }
        __syncthreads();
        f32x4 acc[4];
#pragma unroll
        for (int ib = 0; ib < 4; ++ib) acc[ib] = (f32x4){0.f, 0.f, 0.f, 0.f};
        const int nks = (wave >> 1) + 1;
        const bf16* wrow = wsb + ((size_t)(h * 128 + wave * 16 + fr)) * 128 + fq * 8;
#pragma unroll
        for (int ks = 0; ks < 4; ++ks) if (ks < nks) {
            const bf16x8 yf = *(const bf16x8*)(wrow + ks * 32);
#pragma unroll
            for (int ib = 0; ib < 4; ++ib) { const bf16x8 xf = *(const bf16x8*)(vt + (ib * 16 + fr) * 136 + ks * 32 + fq * 8); acc[ib] = MFMA16(xf, yf, acc[ib]); }
        }
        const int t = wave * 16 + fr; const float bias = bsp[h * 128 + t];
#pragma unroll
        for (int ib = 0; ib < 4; ++ib) {
            const size_t off = (size_t)(tok0 + t) * D + cb + ib * 16 + fq * 4;
            const u32x2 w = *(const u32x2*)(ug + off);
            u32x2 o; o.x = pk2(blo(w.x) * (acc[ib][0] + bias), bhi(w.x) * (acc[ib][1] + bias)); o.y = pk2(blo(w.y) * (acc[ib][2] + bias), bhi(w.y) * (acc[ib][3] + bias));
            *(u32x2*)(ug + off) = o;
        }
        __syncthreads();
    }
}
__device__ __forceinline__ void s5_chunk_sums(const Params& P, int wave, int lane) {
    { const int tid = otid(); lane = tid & 63; wave = __builtin_amdgcn_readfirstlane(tid >> 6); }
    const int fr = lane & 15, fq = lane >> 4;
    const int gw = blockIdx.x * 8 + wave, NGW = gridDim.x * 8;
    const bf16* ps = (const bf16*)(P.ws + WS_B3); const bf16* WS_ = (const bf16*)(P.ws + WS_WS); float* Sc = (float*)(P.ws + WS_SC);
    for (int wt = gw; wt < 1024; wt += NGW) {
        const int g = wt & 63, mt2 = wt >> 6, rA = mt2 * 32 + fr, rB = rA + 16;
        f32x4 acc[2][8];
#pragma unroll
        for (int i = 0; i < 2; ++i)
#pragma unroll
            for (int nb = 0; nb < 8; ++nb) acc[i][nb] = (f32x4){0.f, 0.f, 0.f, 0.f};
        const bf16* pa = ps + ((size_t)rA * 32 + (fq >> 1)) * D + g * 16 + (fq & 1) * 8;
        const bf16* pb = ps + ((size_t)rB * 32 + (fq >> 1)) * D + g * 16 + (fq & 1) * 8;
        const bf16* pw = WS_ + ((size_t)g * 128 + fr) * 512 + fq * 8;
#pragma unroll 2
        for (int ks = 0; ks < 16; ++ks) {
            const bf16x8 ya = *(const bf16x8*)(pa + (size_t)ks * 2 * D), yb = *(const bf16x8*)(pb + (size_t)ks * 2 * D);
#pragma unroll
            for (int nb = 0; nb < 8; ++nb) { const bf16x8 xw = *(const bf16x8*)(pw + (size_t)nb * 16 * 512 + ks * 32); acc[0][nb] = MFMA16(xw, ya, acc[0][nb]); acc[1][nb] = MFMA16(xw, yb, acc[1][nb]); }
        }
#pragma unroll
        for (int nb = 0; nb < 8; ++nb) {
            *(f32x4*)(Sc + ((size_t)rA * 64 + g) * 128 + nb * 16 + fq * 4) = acc[0][nb];
            *(f32x4*)(Sc + ((size_t)rB * 64 + g) * 128 + nb * 16 + fq * 4) = acc[1][nb];
        }
    }
}
__device__ __forceinline__ void sample_mix(const Params& P, int l, unsigned char* lds, int wave, int lane) {
    { const int tid = otid(); lane = tid & 63; wave = __builtin_amdgcn_readfirstlane(tid >> 6); }
    const int gw = blockIdx.x * 8 + wave, NGW = gridDim.x * 8;
    unsigned char* ws = P.ws;
    const float* s_gu = (const float*)(ws + WS_SMALL); const float* s_sga = s_gu + NS * D; const float* s_gv = s_sga + NS * D; const float* s_ps = s_gv + NS * D;
    float* s_apart = (float*)(ws + WS_SMALL) + 5 * NS * D;
    for (int i = gw; i < NS; i += NGW) {
        f32x4 v[4]; float ss = 0.f;
#pragma unroll
        for (int j = 0; j < 4; ++j) { v[j] = *(const f32x4*)(s_gv + (size_t)i * D + (lane + 64 * j) * 4); ss += (v[j].x * v[j].x + v[j].y * v[j].y) + (v[j].z * v[j].z + v[j].w * v[j].w); }
        const float r = rsqrtf(wave_sum(ss) * (1.f / D) + EPS);
#pragma unroll
        for (int j = 0; j < 4; ++j) {
            const int d = (lane + 64 * j) * 4, h = d >> 8;
            const f32x4 vn = v[j] * r * *(const f32x4*)(P.in[I_GV] + l * D + d);
            *(f32x4*)(P.out + O_V + ((size_t)l * NS + i) * D + d) = vn;
            const float w00 = P.in[I_WSP][(size_t)(l * 4 + h) * 128 * 128], b0 = P.in[I_BSP][(l * 4 + h) * 128];
            const f32x4 mixed = vn * w00 + b0;
            *(f32x4*)(s_apart + (size_t)i * D + d) = *(const f32x4*)(s_gu + (size_t)i * D + d) * *(const f32x4*)(s_sga + (size_t)i * D + d) * mixed;
        }
    }
    const float2* abar_f = (const float2*)(ws + WS_S5F); const float2* bbar_f = abar_f + 8192;
    bf16* zs = (bf16*)(ws + WS_B0) + (size_t)NP * D;
    float* sw = (float*)(lds + wave * 512);
    for (int wt = gw; wt < NS * 64; wt += NGW) {
        const int i = wt >> 6, g = wt & 63, p = lane;
        const float* xs = s_ps + (size_t)i * D + g * 16;
        float xr[16];
#pragma unroll
        for (int j = 0; j < 4; ++j) { const f32x4 t = *(const f32x4*)(xs + 4 * j); xr[4 * j] = t.x; xr[4 * j + 1] = t.y; xr[4 * j + 2] = t.z; xr[4 * j + 3] = t.w; }
        const float2* bb = bbar_f + ((size_t)g * 64 + p) * 16;
        float bur = 0.f, bui = 0.f;
#pragma unroll
        for (int k = 0; k < 16; ++k) { const float2 b = bb[k]; bur += b.x * xr[k]; bui += b.y * xr[k]; }
        const float2 a = abar_f[g * 64 + p];
        const size_t si = (((size_t)l * NS + i) * 64 + g) * 64 + p;
        const float h0r = P.in[I_SRE][si], h0i = P.in[I_SIM][si];
        const float hr = a.x * h0r - a.y * h0i + bur, hi = a.x * h0i + a.y * h0r + bui;
        P.out[O_RS + si] = hr; P.out[O_IS + si] = hi;
        sw[p] = hr; sw[64 + p] = hi;
        LDS_FENCE();
        const int h = lane & 15, part = lane >> 4;
        const float* cr = P.in[I_CRE] + (((size_t)l * 64 + g) * 16 + h) * 64 + part * 16; const float* ci = P.in[I_CIM] + (((size_t)l * 64 + g) * 16 + h) * 64 + part * 16;
        float s = 0.f;
#pragma unroll
        for (int k = 0; k < 16; ++k) s += cr[k] * sw[part * 16 + k] - ci[k] * sw[64 + part * 16 + k];
        s += __shfl_xor(s, 16); s += __shfl_xor(s, 32);
        if (part == 0) { const float y = s + P.in[I_DSK][l * D + g * 16 + h] * xs[h]; zs[(size_t)i * D + g * 16 + h] = (bf16)f2bf(gelu_t(y)); }
        LDS_FENCE();
    }
}
__device__ __forceinline__ void s5_scan(const Params& P, int l) {
    const int gt = blockIdx.x * 512 + otid();
    if (gt >= 8 * 64 * 64) return;
    const int p = gt & 63, g = (gt >> 6) & 63, b = gt >> 12;
    const float2 aT = ((const float2*)(P.ws + WS_S5F))[4096 + g * 64 + p];
    const float* Sc = (const float*)(P.ws + WS_SC); unsigned* Hin = (unsigned*)(P.ws + WS_HIN);
    float hr = 0.f, hi = 0.f;
    for (int c0 = 0; c0 < 64; c0 += 8) {
        float2 s[8];
#pragma unroll
        for (int j = 0; j < 8; ++j) s[j] = *(const float2*)(Sc + (((size_t)(b * 64 + c0 + j)) * 64 + g) * 128 + 2 * p);
#pragma unroll
        for (int j = 0; j < 8; ++j) {
            Hin[(((size_t)(b * 64 + c0 + j)) * 64 + g) * 64 + p] = pk2(hr, hi);
            const float nr = aT.x * hr - aT.y * hi + s[j].x, ni = aT.x * hi + aT.y * hr + s[j].y; hr = nr; hi = ni;
        }
    }
    const size_t oi = (((size_t)l * 8 + b) * 64 + g) * 64 + p;
    P.out[O_RP + oi] = hr; P.out[O_IP + oi] = hi;
}
template <int TH>
__device__ __forceinline__ void s5_out_half(const unsigned char* lwy, const unsigned char* lkt, const bf16* ps, const bf16* Hin, bf16* zb, const float* dskp, int R, int g, int fr, int fq) {
    constexpr int NT = 8, T0 = TH * NT, NX = 4 * (TH + 1);
    bf16x8 xf[NX];
    const bf16* px = ps + ((size_t)R * 32 + (fq >> 1)) * D + g * 16 + (fq & 1) * 8;
#pragma unroll
    for (int i = 0; i < NX; ++i) xf[i] = *(const bf16x8*)(px + (size_t)i * 2 * D);
    f32x4 acc[NT];
#pragma unroll
    for (int t = 0; t < NT; ++t) acc[t] = (f32x4){0.f, 0.f, 0.f, 0.f};
    {
        bf16x8 hf[4];
#pragma unroll
        for (int k = 0; k < 4; ++k) hf[k] = *(const bf16x8*)(Hin + ((size_t)R * 64 + g) * 128 + k * 32 + fq * 8);
#pragma unroll
        for (int t = 0; t < NT; ++t)
        {
#pragma unroll
            for (int k = 0; k < 4; ++k) { const int row = (T0 + t) * 16 + fr; const bf16x8 xw = *(const bf16x8*)(lwy + row * 256 + (((k * 4 + fq) ^ fr) << 4)); acc[t] = MFMA16(xw, hf[k], acc[t]); }
            if ((t & 3) == 3) __builtin_amdgcn_sched_barrier(0);
        }
    }
#pragma unroll
    for (int dl = 0; dl < 32; ++dl) {
        const bf16x8 xk = *(const bf16x8*)(lkt + ((dl + 1 - (fq >> 1)) * 256 + fr * 16 + (fq & 1) * 8) * 2);
#pragma unroll
        for (int i = 0; i < NX; ++i) if (2 * i + dl >= T0 && 2 * i + dl < T0 + NT) acc[2 * i + dl - T0] = MFMA16(xk, xf[i], acc[2 * i + dl - T0]);
        if ((dl & 3) == 3) __builtin_amdgcn_sched_barrier(0);
    }
    const f32x4 dsk = *(const f32x4*)(dskp + g * 16 + fq * 4);
#pragma unroll
    for (int t = 0; t < NT; ++t) {
        const size_t off = ((size_t)R * 32 + T0 + t) * D + g * 16 + fq * 4;
        const u32x2 w = *(const u32x2*)(ps + off);
        u32x2 o; o.x = pk2(gelu_t(acc[t][0] + dsk[0] * blo(w.x)), gelu_t(acc[t][1] + dsk[1] * bhi(w.x)));
        o.y = pk2(gelu_t(acc[t][2] + dsk[2] * blo(w.y)), gelu_t(acc[t][3] + dsk[3] * bhi(w.y)));
        *(u32x2*)(zb + off) = o;
    }
}
__device__ __forceinline__ void s5_output(const Params& P, int l, unsigned char* lds, int wave, int lane) {
    const int tid = otid(); lane = tid & 63; wave = __builtin_amdgcn_readfirstlane(tid >> 6);
    const int fr = lane & 15, fq = lane >> 4;
    unsigned char* ws = P.ws;
    const bf16* ps = (const bf16*)(ws + WS_B3); const bf16* Hin = (const bf16*)(ws + WS_HIN); bf16* zb = (bf16*)(ws + WS_B0);
    const bf16* WY_ = (const bf16*)(ws + WS_WY); const bf16* ktab = (const bf16*)(ws + WS_KTAB);
    unsigned char* lwy = lds; unsigned char* lkt = lds + 131072;
    for (int wt = blockIdx.x; wt < 256; wt += gridDim.x) {
        const int g = wt >> 2, q = wt & 3;
#pragma unroll 4
        for (int i = 0; i < 16; ++i) { const int e = tid + i * 512, row = e >> 4, ch = e & 15;
            *(u32x4*)(lwy + row * 256 + ((ch ^ (row & 15)) << 4)) = *(const u32x4*)(WY_ + ((size_t)g * 512 + row) * 128 + ch * 8); }
        for (int e = tid; e < 1056; e += 512) *(u32x4*)(lkt + e * 16) = *(const u32x4*)(ktab + (size_t)g * 33 * 256 + e * 8);
        const int R = (q * 8 + wave) * 16 + fr;
        __syncthreads();
        s5_out_half<0>(lwy, lkt, ps, Hin, zb, P.in[I_DSK] + l * D, R, g, fr, fq);
        s5_out_half<1>(lwy, lkt, ps, Hin, zb, P.in[I_DSK] + l * D, R, g, fr, fq);
        s5_out_half<2>(lwy, lkt, ps, Hin, zb, P.in[I_DSK] + l * D, R, g, fr, fq);
        s5_out_half<3>(lwy, lkt, ps, Hin, zb, P.in[I_DSK] + l * D, R, g, fr, fq);
        __syncthreads();
    }
}

#define XB_TMO      128
#define XB_XCNT(j)  (256  + 64 * (j))
#define XB_XSUB(j)  (1280 + 64 * (j))
#define XB_XGEN(j)  (2304 + 64 * (j))
#define XB_TOP      3328
#define XB_TOPGEN   3392
#define XCD_BAR_WORDS 3456
#define XB_SPIN_CAP (1u << 18)

__device__ __forceinline__ unsigned xb_ld(unsigned* p)              { return __hip_atomic_load(p, __ATOMIC_RELAXED, __HIP_MEMORY_SCOPE_AGENT); }
__device__ __forceinline__ unsigned xb_add(unsigned* p, unsigned v) { return __hip_atomic_fetch_add(p, v, __ATOMIC_RELAXED, __HIP_MEMORY_SCOPE_AGENT); }
__device__ __forceinline__ unsigned xb_xcc_id() { return (unsigned)__builtin_amdgcn_s_getreg((3 << 11) | 20) & 0xFu; }
#define XB_SPIN(cond, bar) do { unsigned _sp = 0; while (cond) { __builtin_amdgcn_s_sleep(1); \
    if ((++_sp & 255u) == 0u) { if (xb_ld(&(bar)[XB_TMO])) break; if (_sp > XB_SPIN_CAP) { atomicAdd(&(bar)[XB_TMO], 1u); break; } } } } while (0)

struct XcdBarrier {
    unsigned* bar; unsigned x;
    volatile LAS unsigned* st;
};

__device__ __forceinline__ XcdBarrier xcd_barrier_post(unsigned* bar, volatile LAS unsigned* st) {
    XcdBarrier b; b.bar = bar; b.x = xb_xcc_id(); b.st = st;
    if (threadIdx.x == 0) (void)xb_add(&bar[XB_XCNT(b.x)], 1u);
    return b;
}
__device__ __forceinline__ void xcd_barrier_complete(unsigned* bar, unsigned x, unsigned& nloc, unsigned& nx) {
    const unsigned G = gridDim.x * gridDim.y * gridDim.z;
    unsigned sum, cnt, mine, sp = 0u;
    for (;;) {
        sum = 0u; cnt = 0u; mine = 0u;
#pragma unroll
        for (unsigned j = 0; j < 16; ++j) { const unsigned c = xb_ld(&bar[XB_XCNT(j)]); sum += c; cnt += (c > 0u) ? 1u : 0u; mine = (j == x) ? c : mine; }
        if (sum == G) break;
        __builtin_amdgcn_s_sleep(1);
        if ((++sp & 255u) == 0u) { if (xb_ld(&bar[XB_TMO])) break; if (sp > XB_SPIN_CAP) { atomicAdd(&bar[XB_TMO], 1u); break; } }
    }
    nloc = mine > 0u ? mine : 1u; nx = cnt > 0u ? cnt : 1u;
}

__device__ __forceinline__ void xcd_barrier(const XcdBarrier& b) {
    asm volatile("s_waitcnt vmcnt(0)" ::: "memory");
    __syncthreads();
    if (threadIdx.x == 0) {
        unsigned* bar = b.bar;
        __builtin_amdgcn_s_waitcnt(0);
        unsigned nloc = b.st[0], nx = b.st[1];
        if (nloc == 0u) { xcd_barrier_complete(bar, b.x, nloc, nx); b.st[0] = nloc; b.st[1] = nx; }
        const unsigned old = xb_add(&bar[XB_XSUB(b.x)], 1u);
        const unsigned gen = old / nloc;
        if (old + 1u == (gen + 1u) * nloc) {
            __builtin_amdgcn_fence(__ATOMIC_RELEASE, "agent");
            asm volatile("s_waitcnt vmcnt(0)" ::: "memory");
            const unsigned og = xb_add(&bar[XB_TOP], 1u);
            const unsigned tg = og / nx;
            if (og + 1u == (tg + 1u) * nx) xb_add(&bar[XB_TOPGEN], 1u);
            else XB_SPIN(xb_ld(&bar[XB_TOPGEN]) == tg, bar);
            __builtin_amdgcn_fence(__ATOMIC_ACQUIRE, "agent");
            xb_add(&bar[XB_XGEN(b.x)], 1u);
            asm volatile("s_waitcnt vmcnt(0)" ::: "memory");
        } else {
            XB_SPIN(xb_ld(&bar[XB_XGEN(b.x)]) == gen, bar);
            __builtin_amdgcn_fence(__ATOMIC_ACQUIRE, "agent");
            asm volatile("s_waitcnt vmcnt(0)" ::: "memory");
        }
    }
    __syncthreads();
}

#define GEMM_PHASE(EpiT, Aptr, Btptr, M_, N_, K_, Eobj) do { pg8::Gemm g_{(const pg8::bf16_t*)(Aptr), (const pg8::bf16_t*)(Btptr), (M_), (N_), (K_)}; pg8::StaticOrder S_; S_.init((M_), (N_), (int)gridDim.x, (int)blockIdx.x); \
    pg8::gemm_phase<EpiT, pg8::StaticOrder, true, true>((PG8_LAS unsigned char*)lds, g_, S_, (Eobj)); } while (0)

__global__ void __launch_bounds__(512, 2) fwd_kernel(Params P) {
    extern __shared__ __attribute__((aligned(16))) unsigned char lds[];
    cg::grid_group grid = cg::this_grid();
    int lane = 0, wave = 0;
    unsigned char* ws = P.ws;
    float* xcur = P.out;
    bf16* B0 = (bf16*)(ws + WS_B0); bf16* B1 = (bf16*)(ws + WS_B1); bf16* B2 = (bf16*)(ws + WS_B2); bf16* B3 = (bf16*)(ws + WS_B3); bf16* B4 = (bf16*)(ws + WS_B4);
    float* modb = (float*)(ws + WS_MOD);
    float* sm = (float*)(ws + WS_SMALL);

    volatile LAS unsigned* stw = (volatile LAS unsigned*)((LAS unsigned char*)lds + (LDS_BYTES - 16));
    unsigned* barw = (unsigned*)(ws + WS_BAR);
    { const int t0 = otid(); if (t0 < 4) stw[t0] = 0u; if (blockIdx.x == 0) for (int e = t0; e < XCD_BAR_WORDS; e += 512) barw[e] = 0u; }
    __syncthreads();
    prep_misc(P, lds, wave, lane);
    __syncthreads();
    prep_layer(P, 0, lds, wave, lane);
    grid.sync();
    const XcdBarrier xb = xcd_barrier_post(barw, stw);
#define GSYNC() xcd_barrier(xb)
#pragma unroll 1
    for (int l = 0; l < 2; ++l) {
        SEpiAda E{modb + (size_t)l * NMODR * NMODC, P.in[I_BADA] + (size_t)l * NMODC};
        small_gemm<9>(lds, (const bf16*)(ws + WS_CSILU), B1 + (size_t)l * NMODC * D, NMODC, D, E, wave, lane);
    }
    GSYNC();

#pragma unroll 1
    for (int l = 0; l < 2; ++l) {
        const float* xP = l ? xcur : P.in[I_XP]; const float* xS = l ? xcur + (size_t)NP * D : P.in[I_XS];
        const float* modl = modb + (size_t)l * NMODR * NMODC;
        if (l == 1) { prep_layer(P, 1, lds, wave, lane); }
        { float* ssq = (float*)(ws + WS_SSQ); for (int e = blockIdx.x * 512 + otid(); e < NP; e += gridDim.x * 512) ssq[e] = 0.f; }
        norm_phase(P, l, xP, xS, P.in[I_G1] + l * D, 0, 1024, wave, lane);
        GSYNC();
        { EpiIn E{B1, B2, B3, B4, (float*)(ws + WS_SSQ)}; GEMM_PHASE(EpiIn, B0, ws + WS_WIN, NP, NIN, D, E); }
        { SEpiIn E{sm, sm + NS * D, sm + 2 * NS * D, sm + 3 * NS * D, sm + 4 * NS * D};
          small_gemm<8>(lds, B0 + (size_t)NP * D, (const bf16*)(ws + WS_WIN), NIN, D, E, wave, lane); }
        GSYNC();
        mix_phase(P, l, lds, wave, lane);
        s5_chunk_sums(P, wave, lane);
        sample_mix(P, l, lds, wave, lane);
        GSYNC();
        s5_scan(P, l);
        GSYNC();
        s5_output(P, l, lds, wave, lane);
        GSYNC();
        { EpiGlu E{B1, B4, B0, P.in[I_BGLU] + l * D}; GEMM_PHASE(EpiGlu, B0, ws + WS_WGLU, NP, D, D, E); }
        { SEpiGlu E{sm + 5 * NS * D, sm + 4 * NS * D, B0 + (size_t)NP * D, P.in[I_BGLU] + l * D, B1 + (size_t)NP * D};
          small_gemm<8>(lds, B0 + (size_t)NP * D, (const bf16*)(ws + WS_WGLU), D, D, E, wave, lane); }
        GSYNC();
        { EpiRes E{xP, xcur, modl + (size_t)128 * NMODC + 2048}; GEMM_PHASE(EpiRes, B1, ws + WS_WOUT, NP, D, D, E); }
        { SEpiRes E{xS, xcur + (size_t)NP * D, modl + 2048};
          small_gemm<8>(lds, B1 + (size_t)NP * D, (const bf16*)(ws + WS_WOUT), D, D, E, wave, lane); }
        GSYNC();
        norm_phase(P, l, xcur, xcur + (size_t)NP * D, P.in[I_G2] + l * D, 3072, 4096, wave, lane);
        GSYNC();
        { EpiFF1 E{B1}; GEMM_PHASE(EpiFF1, B0, ws + WS_WFF1, NP, FF, D, E); }
        { SEpiFF1 E{B1 + (size_t)NP * FF}; small_gemm<8>(lds, B0 + (size_t)NP * D, (const bf16*)(ws + WS_WFF1), FF, D, E, wave, lane); }
        GSYNC();
        { EpiRes E{xcur, xcur, modl + (size_t)128 * NMODC + 5120}; GEMM_PHASE(EpiRes, B1, ws + WS_WFF2, NP, D, FF, E); }
        { SEpiRes E{xcur + (size_t)NP * D, xcur + (size_t)NP * D, modl + 5120};
          small_gemm<8>(lds, B1 + (size_t)NP * FF, (const bf16*)(ws + WS_WFF2), D, FF, E, wave, lane); }
        GSYNC();
    }
    final_norm(P, wave, lane);
}

extern "C" void kernel_launch(void* const* d_in, const int* in_sizes, int n_in, void* d_out, int out_size, void* d_ws, size_t ws_size, hipStream_t stream) {
    static int grid_blocks = 0;
    if (grid_blocks == 0) {
        if (n_in != 28 || ws_size < WS_END) { fprintf(stderr, "kernel_launch: unexpected n_in %d / ws_size %zu (need %zu)\n", n_in, ws_size, (size_t)WS_END); grid_blocks = -1; return; }
        int dev = 0, cus = 0, per_cu = 0;
        hipGetDevice(&dev); hipDeviceGetAttribute(&cus, hipDeviceAttributeMultiprocessorCount, dev);
        if (hipFuncSetAttribute((const void*)fwd_kernel, hipFuncAttributeMaxDynamicSharedMemorySize, LDS_BYTES) != hipSuccess) { fprintf(stderr, "kernel_launch: hipFuncSetAttribute failed\n"); grid_blocks = -1; return; }
        if (hipOccupancyMaxActiveBlocksPerMultiprocessor(&per_cu, (const void*)fwd_kernel, 512, LDS_BYTES) != hipSuccess || per_cu < 1) { fprintf(stderr, "kernel_launch: occupancy query says %d blocks per CU\n", per_cu); grid_blocks = -1; return; }
        grid_blocks = cus;
    }
    if (grid_blocks < 0) return;
    Params p{};
    for (int i = 0; i < 28; ++i) p.in[i] = (const float*)d_in[i];
    p.out = (float*)d_out; p.ws = (unsigned char*)d_ws;
    void* args[] = {&p};
    hipError_t e = hipLaunchCooperativeKernel((void*)fwd_kernel, dim3(grid_blocks), dim3(512), args, LDS_BYTES, stream);
    if (e != hipSuccess) fprintf(stderr, "cooperative launch failed: %s (grid %d)\n", hipGetErrorString(e), grid_blocks);
}
```
